# Optimizing an MI355X kernel written in HIP

```python
import math
import jax
import jax.numpy as jnp
from jax import lax
import numpy as np

D_MODEL = 1024
BATCH = 16
SEQ = 4096
DEPTH = 4

GRID_W = 64
CTX_LEN = 256
EPS = 1e-6
ROPE_THETA = 10000.0
Q_BLOCK = 128

BRANCH_WIDTH = D_MODEL // 2
N_BRANCH = 3
DA_HEADS = 4
DA_V_DIM = BRANCH_WIDTH // DA_HEADS
DA_QK_DIM = DA_V_DIM // 2
POOL_WINDOWS = (2, 4, 8, 16)
POOL_GROUPS = 4
POOL_GROUP = BRANCH_WIDTH // POOL_GROUPS
WA_HEAD_DIM = 64
WA_HEADS = BRANCH_WIDTH // WA_HEAD_DIM
WA_KV_HEADS = 2
WA_GROUP = WA_HEADS // WA_KV_HEADS
WA_WINDOW = 128
WA_BLOCK = 128
D_FF = ((8 * D_MODEL + 3 * 256 - 1) // (3 * 256)) * 256
IN_SPLITS = (
    DA_HEADS * 2 * DA_QK_DIM,
    DA_HEADS * 2 * DA_QK_DIM,
    DA_HEADS * DA_V_DIM,
    BRANCH_WIDTH,
    WA_HEADS * WA_HEAD_DIM,
    WA_KV_HEADS * WA_HEAD_DIM,
    WA_KV_HEADS * WA_HEAD_DIM,
    N_BRANCH * D_MODEL,
)
IN_WIDTH = (3 * DA_HEADS * 2 * DA_QK_DIM - DA_HEADS * 2 * DA_QK_DIM + DA_HEADS * DA_V_DIM
            + BRANCH_WIDTH + WA_HEADS * WA_HEAD_DIM + 2 * WA_KV_HEADS * WA_HEAD_DIM
            + N_BRANCH * D_MODEL)

kernel_name = 'hybrid_diffattn_pool_swa_adaln_block'


def rms_norm(x, g):
    xf = x.astype(jnp.float32)
    y = xf * lax.rsqrt(jnp.mean(xf * xf, axis=-1, keepdims=True) + EPS)
    return (y * g.astype(jnp.float32)).astype(x.dtype)


def modulate(x, g, shift, scale):
    return rms_norm(x, g) * (1 + scale) + shift


def axial_rope_tables(n, dim):
    rows = n // GRID_W
    row = jnp.repeat(jnp.arange(rows, dtype=jnp.float32), GRID_W)
    col = jnp.tile(jnp.arange(GRID_W, dtype=jnp.float32), rows)
    n_freq = dim // 4
    inv = ROPE_THETA ** (-jnp.arange(n_freq, dtype=jnp.float32) / n_freq)
    ang = jnp.concatenate([row[:, None] * inv, col[:, None] * inv], axis=-1)
    return jnp.cos(ang), jnp.sin(ang)


def apply_rope(x, cos, sin):
    shp = (cos.shape[0],) + (1,) * (x.ndim - 3) + (cos.shape[1],)
    cs = cos.reshape(shp).astype(x.dtype)
    sn = sin.reshape(shp).astype(x.dtype)
    x1 = x[..., 0::2]
    x2 = x[..., 1::2]
    return jnp.stack([x1 * cs - x2 * sn, x1 * sn + x2 * cs], axis=-1).reshape(x.shape)


def split_mixer_inputs(z):
    b, n = z.shape[:2]
    parts = []
    start = 0
    for w in IN_SPLITS:
        parts.append(z[..., start:start + w])
        start += w
    qa, ka, va, u, qw, kw, vw, gates = parts
    return (qa.reshape(b, n, DA_HEADS, 2, DA_QK_DIM),
            ka.reshape(b, n, DA_HEADS, 2, DA_QK_DIM),
            va.reshape(b, n, DA_HEADS, DA_V_DIM),
            u,
            qw.reshape(b, n, WA_HEADS, WA_HEAD_DIM),
            kw.reshape(b, n, WA_KV_HEADS, WA_HEAD_DIM),
            vw.reshape(b, n, WA_KV_HEADS, WA_HEAD_DIM),
            gates)


def diff_attention(q, k, v, lam, g_sub, lam_init):
    b, nq = q.shape[:2]
    nb = nq // Q_BLOCK
    qb = q.reshape((b, nb, Q_BLOCK) + q.shape[2:]).swapaxes(0, 1)
    scale = DA_QK_DIM ** -0.5

    def one(qblk):
        s = jnp.einsum('bqhsd,bkhsd->bhsqk', qblk, k).astype(jnp.float32) * scale
        p = jax.nn.softmax(s, axis=-1)
        a = p[:, :, 0] - lam * p[:, :, 1]
        return jnp.einsum('bhqk,bkhe->bqhe', a.astype(v.dtype), v)

    o = lax.map(one, qb).swapaxes(0, 1).reshape(b, nq, DA_HEADS, DA_V_DIM)
    o = rms_norm(o, g_sub) * (1 - lam_init)
    return o.reshape(b, nq, DA_HEADS * DA_V_DIM)


def multiscale_pool(u, w_pool, pool_scale):
    b, n, _ = u.shape
    uf = u.reshape(b, n, POOL_GROUPS, POOL_GROUP).astype(jnp.float32)
    csum = jnp.concatenate([jnp.zeros((b, 1, POOL_GROUPS, POOL_GROUP), jnp.float32),
                            lax.cumsum(uf, axis=1)], axis=1)
    w = jnp.array(POOL_WINDOWS, dtype=jnp.int32)
    t = jnp.arange(n, dtype=jnp.int32)[:, None]
    lo = jnp.clip(t - w // 2, 0, n)
    hi = jnp.clip(t + w - w // 2, 0, n)
    grp = jnp.arange(POOL_GROUPS)[None, :]
    wsum = csum[:, hi, grp] - csum[:, lo, grp]
    count = (hi - lo).astype(jnp.float32)[..., None]
    pooled = (wsum / count - uf).astype(u.dtype)
    y = jnp.einsum('bngc,gcd->bngd', pooled, w_pool).reshape(b, n, BRANCH_WIDTH)
    return y * pool_scale


def sink_softmax(s, sink):
    sk = sink.astype(jnp.float32)[:, :, None, None]
    m = jnp.maximum(jnp.max(s, axis=-1, keepdims=True), sk)
    e = jnp.exp(s - m)
    return e / (jnp.sum(e, axis=-1, keepdims=True) + jnp.exp(sk - m))


def window_sink_attention(q, k, v, kc, vc, sink):
    b, n = q.shape[:2]
    nb = n // WA_BLOCK
    pad = ((0, 0), (WA_BLOCK, WA_BLOCK), (0, 0), (0, 0))
    kp = jnp.pad(k, pad)
    vp = jnp.pad(v, pad)
    qb = q.reshape(b, nb, WA_BLOCK, WA_KV_HEADS, WA_GROUP, WA_HEAD_DIM).swapaxes(0, 1)
    sink_g = sink.reshape(WA_KV_HEADS, WA_GROUP)
    scale = WA_HEAD_DIM ** -0.5
    band = 3 * WA_BLOCK
    rel = jnp.arange(band)[None, :] - WA_BLOCK - jnp.arange(WA_BLOCK)[:, None]
    band_ok = jnp.abs(rel) <= WA_WINDOW

    def one(args):
        i, qblk = args
        kb = lax.dynamic_slice_in_dim(kp, i * WA_BLOCK, band, axis=1)
        vb = lax.dynamic_slice_in_dim(vp, i * WA_BLOCK, band, axis=1)
        kpos = (i - 1) * WA_BLOCK + jnp.arange(band)
        ok = band_ok & ((kpos >= 0) & (kpos < n))[None, :]
        s_band = jnp.einsum('bqkgd,bjkd->bkgqj', qblk, kb).astype(jnp.float32) * scale
        s_band = jnp.where(ok, s_band, -jnp.inf)
        s_ctx = jnp.einsum('bqkgd,bjkd->bkgqj', qblk, kc).astype(jnp.float32) * scale
        p = sink_softmax(jnp.concatenate([s_band, s_ctx], axis=-1), sink_g)
        vv = jnp.concatenate([vb, vc], axis=1)
        return jnp.einsum('bkgqj,bjkd->bqkgd', p.astype(v.dtype), vv)

    o = lax.map(one, (jnp.arange(nb, dtype=jnp.int32), qb))
    return o.swapaxes(0, 1).reshape(b, n, WA_HEADS * WA_HEAD_DIM)


def context_sink_attention(q, k, v, sink):
    b, n = q.shape[:2]
    qg = q.reshape(b, n, WA_KV_HEADS, WA_GROUP, WA_HEAD_DIM)
    s = jnp.einsum('bqkgd,bjkd->bkgqj', qg, k).astype(jnp.float32) * WA_HEAD_DIM ** -0.5
    p = sink_softmax(s, sink.reshape(WA_KV_HEADS, WA_GROUP))
    o = jnp.einsum('bkgqj,bjkd->bqkgd', p.astype(v.dtype), v)
    return o.reshape(b, n, WA_HEADS * WA_HEAD_DIM)


def merge_branches(ya, yb, yc, gates, w_branch, w_out):
    b, n = gates.shape[:2]
    g = jax.nn.sigmoid(gates.reshape(b, n, N_BRANCH, D_MODEL))
    m = (g[:, :, 0] * (ya @ w_branch[0]) + g[:, :, 1] * (yb @ w_branch[1])
         + g[:, :, 2] * (yc @ w_branch[2]))
    return m @ w_out


def swiglu(h, w_in, w_out):
    gate, up = jnp.split(h @ w_in, 2, axis=-1)
    return (jax.nn.silu(gate) * up) @ w_out


def setup_inputs(seed: int = 0) -> dict:
    key = jax.random.key(seed)
    ks = jax.random.split(key, 17)

    def nrm(k, shape, s):
        return jax.random.normal(k, shape, jnp.float32) * s

    return {
        'x': nrm(ks[0], (BATCH, SEQ, D_MODEL), 1.0),
        'c': nrm(ks[1], (BATCH, D_MODEL), 1.0),
        'ctx': nrm(ks[2], (BATCH, CTX_LEN, D_MODEL), 1.0),
        'c_ctx': nrm(ks[3], (D_MODEL,), 1.0),
        'w_ada': nrm(ks[4], (DEPTH, D_MODEL, 6 * D_MODEL), 0.5 * D_MODEL ** -0.5),
        'b_ada': nrm(ks[5], (DEPTH, 6 * D_MODEL), 0.02),
        'norm_g': 1.0 + nrm(ks[6], (DEPTH, 4, D_MODEL), 0.02),
        'w_in': nrm(ks[7], (DEPTH, D_MODEL, IN_WIDTH), D_MODEL ** -0.5),
        'da_lambda': nrm(ks[8], (DEPTH, 4, DA_QK_DIM), 0.1),
        'da_subln_g': 1.0 + nrm(ks[9], (DEPTH, DA_V_DIM), 0.02),
        'pool_w': nrm(ks[10], (DEPTH, POOL_GROUPS, POOL_GROUP, POOL_GROUP), POOL_GROUP ** -0.5),
        'pool_scale': 1.0 + nrm(ks[11], (DEPTH, BRANCH_WIDTH), 0.02),
        'wa_sink': nrm(ks[12], (DEPTH, WA_HEADS), 0.5),
        'w_branch': nrm(ks[13], (DEPTH, N_BRANCH, BRANCH_WIDTH, D_MODEL), BRANCH_WIDTH ** -0.5),
        'w_out': nrm(ks[14], (DEPTH, D_MODEL, D_MODEL), D_MODEL ** -0.5),
        'w_ffn_in': nrm(ks[15], (DEPTH, D_MODEL, 2 * D_FF), D_MODEL ** -0.5),
        'w_ffn_out': nrm(ks[16], (DEPTH, D_FF, D_MODEL), D_FF ** -0.5),
    }


def reference(x, c, ctx, c_ctx, w_ada, b_ada, norm_g, w_in, da_lambda, da_subln_g,
              pool_w, pool_scale, wa_sink, w_branch, w_out, w_ffn_in, w_ffn_out):
    n = x.shape[1]
    cos_a, sin_a = axial_rope_tables(n, DA_QK_DIM)
    cos_w, sin_w = axial_rope_tables(n, WA_HEAD_DIM)
    xc = ctx
    for l in range(DEPTH):
        mod_x = jnp.split((jax.nn.silu(c) @ w_ada[l] + b_ada[l])[:, None, :], 6, axis=-1)
        mod_c = jnp.split((jax.nn.silu(c_ctx) @ w_ada[l] + b_ada[l])[None, None, :], 6, axis=-1)
        lam_init = 0.8 - 0.6 * math.exp(-0.3 * l)
        lp = da_lambda[l].astype(jnp.float32)
        lam = jnp.exp(jnp.sum(lp[0] * lp[1])) - jnp.exp(jnp.sum(lp[2] * lp[3])) + lam_init

        hc = modulate(xc, norm_g[l, 0], mod_c[0], mod_c[1])
        qac, kac, vac, uc, qwc, kwc, vwc, gatec = split_mixer_inputs(hc @ w_in[l])

        h = modulate(x, norm_g[l, 0], mod_x[0], mod_x[1])
        qa, ka, va, u, qw, kw, vw, gate = split_mixer_inputs(h @ w_in[l])
        qa = apply_rope(qa, cos_a, sin_a)
        ka = apply_rope(ka, cos_a, sin_a)
        qw = apply_rope(qw, cos_w, sin_w)
        kw = apply_rope(kw, cos_w, sin_w)
        ya = diff_attention(qa, jnp.concatenate([ka, kac], axis=1),
                            jnp.concatenate([va, vac], axis=1), lam, da_subln_g[l], lam_init)
        yb = multiscale_pool(u, pool_w[l], pool_scale[l])
        yc = window_sink_attention(qw, kw, vw, kwc, vwc, wa_sink[l])
        mix = merge_branches(ya, yb, yc, gate, w_branch[l], w_out[l])
        x = x + mod_x[2] * rms_norm(mix, norm_g[l, 1])
        h2 = modulate(x, norm_g[l, 2], mod_x[3], mod_x[4])
        x = x + mod_x[5] * rms_norm(swiglu(h2, w_ffn_in[l], w_ffn_out[l]), norm_g[l, 3])

        if l < DEPTH - 1:
            yac = diff_attention(qac, kac, vac, lam, da_subln_g[l], lam_init)
            ybc = multiscale_pool(uc, pool_w[l], pool_scale[l])
            ycc = context_sink_attention(qwc, kwc, vwc, wa_sink[l])
            mixc = merge_branches(yac, ybc, ycc, gatec, w_branch[l], w_out[l])
            xc = xc + mod_c[2] * rms_norm(mixc, norm_g[l, 1])
            h2c = modulate(xc, norm_g[l, 2], mod_c[3], mod_c[4])
            xc = xc + mod_c[5] * rms_norm(swiglu(h2c, w_ffn_in[l], w_ffn_out[l]), norm_g[l, 3])
    return x
```

```cpp
#include <hip/hip_runtime.h>
#include <hip/hip_cooperative_groups.h>
#include <cstdio>
#include <cstdint>
namespace cg = cooperative_groups;

#define LAS __attribute__((address_space(3)))
typedef unsigned short bf16_t;
typedef short bf16x8 __attribute__((ext_vector_type(8)));
typedef short s16x4 __attribute__((ext_vector_type(4)));
typedef float f32x4 __attribute__((ext_vector_type(4)));
typedef float f32x16 __attribute__((ext_vector_type(16)));
typedef unsigned u32x4 __attribute__((ext_vector_type(4)));
typedef unsigned u32x2 __attribute__((ext_vector_type(2)));
#define DI __device__ __forceinline__
#define GAS __attribute__((address_space(1)))

constexpr int NBATCH = 16, SEQ = 4096, CTXL = 256, NB = SEQ + CTXL  , ROWS = NBATCH * NB  ;
constexpr int DM = 1024, DEPTH = 4, INW = 5888, DFF = 2816, ZLD = INW, MODW = 6 * DM, NMOD = 17;
constexpr float EPS = 1e-6f;
constexpr int ZC_QA = 0, ZC_KA = 512, ZC_VA = 1024, ZC_U = 1536, ZC_QW = 2048, ZC_KW = 2560, ZC_VW = 2688, ZC_G = 2816, ZC_M = 1024, ZC_PL = 512;
constexpr size_t MiB = 1u << 20;
constexpr size_t WS_LAM = 0, WS_TAB = 4096, WS_BAR = 128 * 1024, WS_MOD = 1 * MiB, WS_ROPE = 3 * MiB, WS_SS = 4 * MiB, WS_WB = 9 * MiB, WS_XC = 42 * MiB, WS_H = 58 * MiB, WS_Z = 194 * MiB, WS_WB2 = 976 * MiB, WS_END = 1010 * MiB;
constexpr size_t WB_IN = 0, WB_BR = (size_t)INW * DM * 2, WB_O = WB_BR + (size_t)DM * 1536 * 2, WB_FI = WB_O + (size_t)DM * DM * 2, WB_FO = WB_FI + (size_t)2 * DFF * DM * 2, WB_END = WB_FO + (size_t)DM * DFF * 2;
static_assert(WS_WB + WB_END <= WS_XC && WS_H + (size_t)ROWS * DM * 2 <= WS_Z && WS_Z + (size_t)ROWS * ZLD * 2 <= WS_WB2 && WS_WB2 + WB_END <= WS_END, "ws map");
__device__ __forceinline__ size_t wb_off(int l) { return (l & 1) ? WS_WB2 : WS_WB; }
constexpr int LDS_BYTES = 147456;

struct Args { const float* in[17]; float* out; unsigned char* ws; };
struct Cx { unsigned char* ws; float* out; const float* const* tab; int G, bx, vcu; __device__ __forceinline__ const float* inp(int i) const { return (const float*)(const GAS float*)tab[i]; } };

DI unsigned f2bf(float f) { unsigned u = __float_as_uint(f); return (u + 0x7fffu + ((u >> 16) & 1u)) >> 16; }
DI unsigned pk2(float lo, float hi) { return f2bf(lo) | (f2bf(hi) << 16); }
DI unsigned pk2c(float lo, float hi) { unsigned r; asm("v_cvt_pk_bf16_f32 %0, %1, %2" : "=v"(r) : "v"(lo), "v"(hi)); return r; }
DI float bflo(unsigned w) { return __uint_as_float(w << 16); }
DI float bfhi(unsigned w) { return __uint_as_float(w & 0xffff0000u); }
DI float wave_sum(float v) {
#pragma unroll
    for (int o = 1; o < 64; o <<= 1) v += __shfl_xor(v, o);
    return v;
}
DI float sigmoidf_(float x) { return __builtin_amdgcn_rcpf(1.f + __expf(-x)); }


#define XB_TMO      128
#define XB_XCNT(j)  (256  + 64 * (j))
#define XB_XSUB(j)  (1280 + 64 * (j))
#define XB_XGEN(j)  (2304 + 64 * (j))
#define XB_TOP      3328
#define XB_TOPGEN   3392
#define XCD_BAR_WORDS 3456
#define XB_SPIN_CAP (1u << 18)
DI unsigned xb_ld(unsigned* p)              { return __hip_atomic_load(p, __ATOMIC_RELAXED, __HIP_MEMORY_SCOPE_AGENT); }
DI unsigned xb_add(unsigned* p, unsigned v) { return __hip_atomic_fetch_add(p, v, __ATOMIC_RELAXED, __HIP_MEMORY_SCOPE_AGENT); }
DI unsigned xb_xcc_id() { return (unsigned)__builtin_amdgcn_s_getreg((3 << 11) | 20) & 0xFu; }
#define XB_SPIN(cond, bar) do { unsigned _sp = 0; while (cond) { __builtin_amdgcn_s_sleep(1); \
    if ((++_sp & 255u) == 0u) { if (xb_ld(&(bar)[XB_TMO])) break; if (_sp > XB_SPIN_CAP) { atomicAdd(&(bar)[XB_TMO], 1u); break; } } } } while (0)
DI void xcd_barrier_complete(unsigned* bar, unsigned x, unsigned& nloc, unsigned& nx) {
    const unsigned G = gridDim.x * gridDim.y * gridDim.z;
    unsigned sum, cnt, mine, sp = 0u;
    for (;;) {
        sum = 0u; cnt = 0u; mine = 0u;
#pragma unroll
        for (unsigned j = 0; j < 16; ++j) { const unsigned c = xb_ld(&bar[XB_XCNT(j)]); sum += c; cnt += (c > 0u) ? 1u : 0u; mine = (j == x) ? c : mine; }
        if (sum == G) break;
        __builtin_amdgcn_s_sleep(1);
        if ((++sp & 255u) == 0u) { if (xb_ld(&bar[XB_TMO])) break; if (sp > XB_SPIN_CAP) { atomicAdd(&bar[XB_TMO], 1u); break; } }
    }
    nloc = mine > 0u ? mine : 1u; nx = cnt > 0u ? cnt : 1u;
}
DI void xcd_barrier(unsigned* bar, volatile LAS unsigned* st) {
    asm volatile("s_waitcnt vmcnt(0)" ::: "memory");
    __syncthreads();
    if (threadIdx.x == 0) {
        const unsigned x = xb_xcc_id();
        __builtin_amdgcn_s_waitcnt(0);
        unsigned nloc = st[0], nx = st[1];
        if (nloc == 0u) { xcd_barrier_complete(bar, x, nloc, nx); st[0] = nloc; st[1] = nx; }
        const unsigned old = xb_add(&bar[XB_XSUB(x)], 1u);
        const unsigned gen = old / nloc;
        if (old + 1u == (gen + 1u) * nloc) {
            __builtin_amdgcn_fence(__ATOMIC_RELEASE, "agent");
            asm volatile("s_waitcnt vmcnt(0)" ::: "memory");
            const unsigned og = xb_add(&bar[XB_TOP], 1u);
            const unsigned tg = og / nx;
            if (og + 1u == (tg + 1u) * nx) xb_add(&bar[XB_TOPGEN], 1u);
            else XB_SPIN(xb_ld(&bar[XB_TOPGEN]) == tg, bar);
            __builtin_amdgcn_fence(__ATOMIC_ACQUIRE, "agent");
            xb_add(&bar[XB_XGEN(x)], 1u);
            asm volatile("s_waitcnt vmcnt(0)" ::: "memory");
        } else {
            XB_SPIN(xb_ld(&bar[XB_XGEN(x)]) == gen, bar);
            __builtin_amdgcn_fence(__ATOMIC_ACQUIRE, "agent");
            asm volatile("s_waitcnt vmcnt(0)" ::: "memory");
        }
    }
    __syncthreads();
}

namespace pg8 {
constexpr int BM = 256, BK = 64, HALF = 128, HTB = HALF * BK * 2, STAGE_BYTES = 8 * HTB, NXCD = 8, WGM = 8;
DI int lds_byte(int r, int c) { const int st = (r >> 4) * 2 + (c >> 5), rr = r & 15, cc = c & 31, ob = rr * 64 + cc * 2; return st * 1024 + (ob ^ (((ob >> 9) & 1) << 5)); }
DI void stage_rc(int b, int& R, int& C) { const int st = b / 1024, sb = b % 1024, swz = sb ^ (((sb >> 9) & 1) << 5); R = (st >> 1) * 16 + swz / 64; C = (st & 1) * 32 + (swz % 64) / 2; }

DI int perm32(int rho) { const int n = rho >> 4, i = rho & 15; return 8 * (i >> 2) + 4 * n + (i & 3); }

struct Unit { const char* A; const char* B; int lda2; int pm, pn, br; };

struct TileOrder {
    int nM, nN, nwg, G, c; bool rev = false;
    DI void init(int nM_, int nN_, int G_, int c_) { nM = nM_; nN = nN_; nwg = nM * nN; G = G_; c = c_; }
    DI bool tile(int i, int& pm, int& pn) const {
        const long L = (long)i * G + c; if (L >= nwg) return false;
        int wgid = (int)L; { const int q = nwg / NXCD, r = nwg % NXCD, xcd = wgid % NXCD; int off = wgid / NXCD; if (rev) off = (xcd < r ? q : q - 1) - off; wgid = (xcd < r ? xcd * (q + 1) : r * (q + 1) + (xcd - r) * q) + off; }
        const int nig = WGM * nN, gid = wgid / nig, fm = gid * WGM, gsz = (nM - fm) < WGM ? (nM - fm) : WGM;
        pm = fm + ((wgid % nig) % gsz); pn = (wgid % nig) / gsz; return true;
    }
};
struct SchedPlain {
    TileOrder T; const char* A; int lda2; const char* B; int ldb2; bool skipctx;
    DI bool next(int i, Unit& u) const { int pm, pn; if (!T.tile(i, pm, pn)) return false; if (skipctx) pm += pm >> 4;
        u.A = A + (size_t)pm * 256 * lda2; u.B = B + (size_t)pn * 256 * ldb2; u.lda2 = lda2; u.pm = pm; u.pn = pn; u.br = 0; return true; }
};
struct SchedMerge {
    TileOrder T; const char* Z; const char* H; const char* Wb; bool skipctx;
    DI bool next(int i, Unit& u) const { const int it = i / 3, br = i - 3 * it; int pm, pn; if (!T.tile(it, pm, pn)) return false; if (skipctx) pm += pm >> 4;
        u.A = Z + (size_t)pm * 256 * (ZLD * 2) + (br == 0 ? ZC_QA * 2 : (br == 1 ? ZC_PL * 2 : ZC_QW * 2)); u.lda2 = ZLD * 2;
        u.B = Wb + (size_t)pn * 256 * (1536 * 2) + br * 1024; u.pm = pm; u.pn = pn; u.br = br; return true; }
};

template <class Epi, class Sched>
DI void gemm_phase(LAS unsigned char* lds, const int lda2, const int ldb2, const int nt, const Sched& S, const Epi& E) {
    int tid_ = threadIdx.x; asm volatile("" : "+v"(tid_));
    const int tid = tid_, wid = __builtin_amdgcn_readfirstlane(tid >> 6), lane = tid & 63, wr = wid >> 2, wc = wid & 3, fr = lane & 15, fq = lane >> 4;
    int R0, C0, R1, C1; stage_rc(tid * 16, R0, C0); stage_rc(tid * 16 + 8192, R1, C1);
    const int Rb0 = (R0 & ~31) + perm32(R0 & 31), Rb1 = (R1 & ~31) + perm32(R1 & 31);
    const unsigned vB0 = (unsigned)(Rb0 * ldb2 + C0 * 2), vB1 = (unsigned)(Rb1 * ldb2 + C1 * 2);
    const size_t kstep = (size_t)(BK * 2);
    const size_t hstepB = (size_t)HALF * ldb2;
    const unsigned ldsw = (unsigned)wid * 1024u;
    const int aoff = lds_byte(wr * 64 + fr, fq * 8), boff = lds_byte(wc * 32 + fr, fq * 8);
#define PG8_SA(b, h) (((b) * 2 + (h)) * HTB)
#define PG8_SB(b, h) ((4 + (b) * 2 + (h)) * HTB)
#define PG8_STAGE(bufoff, gbase, V0, V1) do { \
        __builtin_amdgcn_global_load_lds((const unsigned*)((const char*)(gbase) + (V0)), (LAS unsigned*)(lds + (bufoff) + ldsw), 16, 0, 0); \
        __builtin_amdgcn_global_load_lds((const unsigned*)((const char*)(gbase) + (V1)), (LAS unsigned*)(lds + (bufoff) + ldsw + 8192), 16, 0, 0); } while (0)
#define PG8_LDA(dst, b, h) do { _Pragma("unroll") for (int m = 0; m < 4; ++m) _Pragma("unroll") for (int k = 0; k < 2; ++k) dst[m][k] = *(const LAS bf16x8*)(lds + PG8_SA(b, h) + aoff + m * 2048 + k * 1024); } while (0)
#define PG8_LDB(dst, b, h) do { _Pragma("unroll") for (int n = 0; n < 2; ++n) _Pragma("unroll") for (int k = 0; k < 2; ++k) dst[n][k] = *(const LAS bf16x8*)(lds + PG8_SB(b, h) + boff + n * 2048 + k * 1024); } while (0)
#define PG8_MMA(ai, bj, At, Bt) do { __builtin_amdgcn_s_setprio(1); _Pragma("unroll") for (int m = 0; m < 4; ++m) _Pragma("unroll") for (int n = 0; n < 2; ++n) _Pragma("unroll") for (int k = 0; k < 2; ++k) \
        acc[ai][bj][m][n] = __builtin_amdgcn_mfma_f32_16x16x32_bf16(Bt[n][k], At[m][k], acc[ai][bj][m][n], 0, 0, 0); __builtin_amdgcn_s_setprio(0); } while (0)
#define PG8_WAIT_V(n) asm volatile("s_waitcnt vmcnt(" #n ")" ::: "memory")
#define PG8_WAIT_L(n) asm volatile("s_waitcnt lgkmcnt(" #n ")" ::: "memory")
#define PG8_BAR __builtin_amdgcn_s_barrier()
#define PG8_SCHED __builtin_amdgcn_sched_barrier(0)
    Unit cur, nxt; int ui = 0;
    if (!S.next(0, cur)) return;
    f32x4 acc[2][2][4][2];
#pragma unroll
    for (int a = 0; a < 2; ++a)
#pragma unroll
        for (int b = 0; b < 2; ++b)
#pragma unroll
            for (int m = 0; m < 4; ++m)
#pragma unroll
                for (int n = 0; n < 2; ++n) acc[a][b][m][n] = (f32x4){0.f, 0.f, 0.f, 0.f};
    bf16x8 At[4][2], B0[2][2], B1[2][2];
    const char* cA = cur.A; const char* cB = cur.B;
    const unsigned vA0 = (unsigned)(R0 * lda2 + C0 * 2), vA1 = (unsigned)(R1 * lda2 + C1 * 2); const size_t hstepA = (size_t)HALF * lda2;
    PG8_STAGE(PG8_SB(0, 0), cB, vB0, vB1); PG8_STAGE(PG8_SB(0, 1), cB + hstepB, vB0, vB1); PG8_STAGE(PG8_SA(0, 0), cA, vA0, vA1); PG8_STAGE(PG8_SA(0, 1), cA + hstepA, vA0, vA1);
    if (wr == 1) PG8_BAR;
    PG8_WAIT_V(2); PG8_BAR;
    PG8_STAGE(PG8_SB(1, 0), cB + kstep, vB0, vB1); PG8_STAGE(PG8_SA(1, 0), cA + kstep, vA0, vA1); PG8_STAGE(PG8_SB(1, 1), cB + hstepB + kstep, vB0, vB1);
    PG8_WAIT_V(6); PG8_BAR;
    for (;;) {
        const bool has_next = S.next(ui + 1, nxt);
        const char* nA = has_next ? nxt.A : cA; const char* nB = has_next ? nxt.B : cB;
        for (int t = 0; t < nt; t += 2) {
            const bool last = (t == nt - 2);
            const char* a1 = cA + (size_t)(t + 1) * kstep;
            const char* a2 = last ? nA : cA + (size_t)(t + 2) * kstep; const char* b2 = last ? nB : cB + (size_t)(t + 2) * kstep;
            const char* a3 = a2 + kstep; const char* b3 = b2 + kstep;
            PG8_LDB(B0, 0, 0); PG8_LDB(B1, 0, 1); PG8_SCHED; PG8_LDA(At, 0, 0); PG8_STAGE(PG8_SA(1, 1), a1 + hstepA, vA0, vA1);
            PG8_WAIT_V(8); PG8_WAIT_L(0); PG8_BAR; PG8_MMA(0, 0, At, B0); PG8_MMA(0, 1, At, B1); PG8_BAR; PG8_SCHED;
            PG8_LDA(At, 0, 1); PG8_STAGE(PG8_SB(0, 0), b2, vB0, vB1); PG8_STAGE(PG8_SB(0, 1), b2 + hstepB, vB0, vB1); PG8_STAGE(PG8_SA(0, 0), a2, vA0, vA1);
            PG8_WAIT_V(8); PG8_WAIT_L(0); PG8_BAR; PG8_MMA(1, 0, At, B0); PG8_MMA(1, 1, At, B1); PG8_BAR; PG8_SCHED;
            PG8_LDB(B0, 1, 0); PG8_LDB(B1, 1, 1); PG8_SCHED; PG8_LDA(At, 1, 0); PG8_STAGE(PG8_SA(0, 1), a2 + hstepA, vA0, vA1);
            PG8_WAIT_V(8); PG8_WAIT_L(0); PG8_BAR; PG8_MMA(0, 0, At, B0); PG8_MMA(0, 1, At, B1); PG8_BAR; PG8_SCHED;
            PG8_LDA(At, 1, 1); PG8_STAGE(PG8_SB(1, 0), b3, vB0, vB1); PG8_STAGE(PG8_SB(1, 1), b3 + hstepB, vB0, vB1); PG8_STAGE(PG8_SA(1, 0), a3, vA0, vA1);
            PG8_WAIT_V(8); PG8_WAIT_L(0); PG8_BAR; PG8_MMA(1, 0, At, B0); PG8_MMA(1, 1, At, B1); PG8_BAR; PG8_SCHED;
        }
        if (wr == 0) PG8_BAR;
        asm volatile("s_nop 7\n\ts_nop 7\n\ts_nop 3" ::: "memory");
        E(acc, cur, wr, wc, fr, fq);
        if (!has_next) break;
        if (E.reset(cur)) {
#pragma unroll
        for (int a = 0; a < 2; ++a)
#pragma unroll
            for (int b = 0; b < 2; ++b)
#pragma unroll
                for (int m = 0; m < 4; ++m)
#pragma unroll
                    for (int n = 0; n < 2; ++n) acc[a][b][m][n] = (f32x4){0.f, 0.f, 0.f, 0.f};
        }
        cur = nxt; cA = nA; cB = nB; ++ui;
        if (wr == 1) PG8_BAR;
    }
    PG8_WAIT_V(0);
    PG8_BAR;
#undef PG8_SA
#undef PG8_SB
#undef PG8_STAGE
#undef PG8_LDA
#undef PG8_LDB
#undef PG8_MMA
#undef PG8_WAIT_V
#undef PG8_WAIT_L
#undef PG8_BAR
#undef PG8_SCHED
}

typedef f32x4 AccT[2][2][4][2];
struct EpiIn {
    bf16_t* Z; const LAS float* ropeT;
    DI bool reset(const Unit&) const { return true; }
    DI void operator()(AccT& acc, const Unit& u, int wr, int wc, int fr, int fq) const {
        asm volatile("" : "+v"(fr), "+v"(fq));
        const int pn = u.pn, pmb = u.pm % 17; const bool lat = pmb != 16;
        const bool gate = pn >= 11;
        const bool ropet = lat && (pn <= 3 || (pn >= 8 && pn <= 10));
#pragma unroll
        for (int ai = 0; ai < 2; ++ai)
#pragma unroll
            for (int m = 0; m < 4; ++m) {
                const int rt = ai * 128 + wr * 64 + m * 16 + fr; const size_t row = (size_t)u.pm * 256 + rt; const int npos = pmb * 256 + rt;
#pragma unroll
                for (int bj = 0; bj < 2; ++bj) {
                    const int col = pn * 256 + bj * 128 + wc * 32 + 8 * fq; f32x4 v0 = acc[ai][bj][m][0], v1 = acc[ai][bj][m][1];
                    if (gate) {
#pragma unroll
                        for (int e = 0; e < 4; ++e) { v0[e] = sigmoidf_(v0[e]); v1[e] = sigmoidf_(v1[e]); }
                    } else if (ropet && !(pn == 10 && bj == 1)) {
                        const int i_ = (col & 63) >> 1; const int pos_ = (i_ < 16) ? (npos >> 6) : (npos & 63);
                        const LAS float* tp = ropeT + (pos_ * 16 + (i_ & 15)) * 2;
                        const f32x4 T0 = *(const LAS f32x4*)tp, T1 = *(const LAS f32x4*)(tp + 4), T2 = *(const LAS f32x4*)(tp + 8), T3 = *(const LAS f32x4*)(tp + 12);
                        f32x4 a, b;
                        a[0] = v0[0] * T0[0] - v0[1] * T0[1]; a[1] = v0[0] * T0[1] + v0[1] * T0[0]; a[2] = v0[2] * T0[2] - v0[3] * T0[3]; a[3] = v0[2] * T0[3] + v0[3] * T0[2];
                        b[0] = v1[0] * T1[0] - v1[1] * T1[1]; b[1] = v1[0] * T1[1] + v1[1] * T1[0]; b[2] = v1[2] * T1[2] - v1[3] * T1[3]; b[3] = v1[2] * T1[3] + v1[3] * T1[2];
                        v0 = a; v1 = b; (void)T2; (void)T3;
                    } else { v0 = v0 + 0.f; v1 = v1 + 0.f; }
                    u32x4 w; w.x = pk2c(v0[0], v0[1]); w.y = pk2c(v0[2], v0[3]); w.z = pk2c(v1[0], v1[1]); w.w = pk2c(v1[2], v1[3]);
                    *(u32x4*)(Z + row * ZLD + col) = w;
                }
            }
    }
};
struct EpiMerge {
    bf16_t* Z;
    DI bool reset(const Unit& u) const { return u.br == 2; }
    DI void operator()(AccT& acc, const Unit& u, int wr, int wc, int fr, int fq) const {
        asm volatile("" : "+v"(fr), "+v"(fq));
        const int br = u.br;
#pragma unroll
        for (int ai = 0; ai < 2; ++ai) {
            u32x4 ga[4][2], gb[4][2];
#pragma unroll
            for (int m = 0; m < 4; ++m) { const size_t row = (size_t)u.pm * 256 + ai * 128 + wr * 64 + m * 16 + fr;
#pragma unroll
                for (int bj = 0; bj < 2; ++bj) { const bf16_t* gp = Z + row * ZLD + ZC_G + br * 1024 + u.pn * 256 + bj * 128 + wc * 32 + 8 * fq;
                    ga[m][bj] = *(const u32x4*)gp; gb[m][bj] = (br < 2) ? *(const u32x4*)(gp + 1024) : (u32x4){0x3f803f80u, 0x3f803f80u, 0x3f803f80u, 0x3f803f80u}; } }
            __builtin_amdgcn_sched_barrier(0);
#pragma unroll
            for (int m = 0; m < 4; ++m) { const size_t row = (size_t)u.pm * 256 + ai * 128 + wr * 64 + m * 16 + fr;
#pragma unroll
                for (int bj = 0; bj < 2; ++bj) { const int col = u.pn * 256 + bj * 128 + wc * 32 + 8 * fq;
                    const u32x4 gw = ga[m][bj], hw = gb[m][bj];
                    f32x4 g0, g1;
                    g0[0] = fmaxf(bflo(gw.x), 1e-18f); g0[1] = fmaxf(bfhi(gw.x), 1e-18f); g0[2] = fmaxf(bflo(gw.y), 1e-18f); g0[3] = fmaxf(bfhi(gw.y), 1e-18f);
                    g1[0] = fmaxf(bflo(gw.z), 1e-18f); g1[1] = fmaxf(bfhi(gw.z), 1e-18f); g1[2] = fmaxf(bflo(gw.w), 1e-18f); g1[3] = fmaxf(bfhi(gw.w), 1e-18f);
                    if (br < 2) {
                        g0[0] *= __builtin_amdgcn_rcpf(fmaxf(bflo(hw.x), 1e-18f)); g0[1] *= __builtin_amdgcn_rcpf(fmaxf(bfhi(hw.x), 1e-18f));
                        g0[2] *= __builtin_amdgcn_rcpf(fmaxf(bflo(hw.y), 1e-18f)); g0[3] *= __builtin_amdgcn_rcpf(fmaxf(bfhi(hw.y), 1e-18f));
                        g1[0] *= __builtin_amdgcn_rcpf(fmaxf(bflo(hw.z), 1e-18f)); g1[1] *= __builtin_amdgcn_rcpf(fmaxf(bfhi(hw.z), 1e-18f));
                        g1[2] *= __builtin_amdgcn_rcpf(fmaxf(bflo(hw.w), 1e-18f)); g1[3] *= __builtin_amdgcn_rcpf(fmaxf(bfhi(hw.w), 1e-18f));
                        acc[ai][bj][m][0] = acc[ai][bj][m][0] * g0; acc[ai][bj][m][1] = acc[ai][bj][m][1] * g1;
                    } else {
                        const f32x4 v0 = acc[ai][bj][m][0] * g0, v1 = acc[ai][bj][m][1] * g1;
                        u32x4 w; w.x = pk2c(v0[0], v0[1]); w.y = pk2c(v0[2], v0[3]); w.z = pk2c(v1[0], v1[1]); w.w = pk2c(v1[2], v1[3]);
                        *(u32x4*)(Z + row * ZLD + ZC_M + col) = w;
                    }
                } }
            __builtin_amdgcn_sched_barrier(0);
        }
    }
};
struct EpiOut {
    bf16_t* O; float* SS;
    DI bool reset(const Unit&) const { return true; }
    DI void operator()(AccT& acc, const Unit& u, int wr, int wc, int fr, int fq) const {
        asm volatile("" : "+v"(fr), "+v"(fq));
#pragma unroll
        for (int ai = 0; ai < 2; ++ai)
#pragma unroll
            for (int m = 0; m < 4; ++m) {
                const int rt = ai * 128 + wr * 64 + m * 16 + fr; const size_t row = (size_t)u.pm * 256 + rt; float s = 0.f;
#pragma unroll
                for (int bj = 0; bj < 2; ++bj) {
                    const int col = u.pn * 256 + bj * 128 + wc * 32 + 8 * fq; const f32x4 v0 = acc[ai][bj][m][0], v1 = acc[ai][bj][m][1];
                    s += (v0[0] * v0[0] + v0[1] * v0[1]) + (v0[2] * v0[2] + v0[3] * v0[3]); s += (v1[0] * v1[0] + v1[1] * v1[1]) + (v1[2] * v1[2] + v1[3] * v1[3]);
                    u32x4 w; w.x = pk2c(v0[0], v0[1]); w.y = pk2c(v0[2], v0[3]); w.z = pk2c(v1[0], v1[1]); w.w = pk2c(v1[2], v1[3]);
                    *(u32x4*)(O + row * DM + col) = w;
                }
                s += __shfl_xor(s, 16); s += __shfl_xor(s, 32);
                if (fq == 0) SS[row * 16 + u.pn * 4 + wc] = s;
            }
    }
};
struct EpiFfn {
    bf16_t* Hd;
    DI bool reset(const Unit&) const { return true; }
    DI void operator()(AccT& acc, const Unit& u, int wr, int wc, int fr, int fq) const {
        asm volatile("" : "+v"(fr), "+v"(fq));
#pragma unroll
        for (int ai = 0; ai < 2; ++ai)
#pragma unroll
            for (int m = 0; m < 4; ++m) {
                const int rt = ai * 128 + wr * 64 + m * 16 + fr; const size_t row = (size_t)u.pm * 256 + rt;
                const int col = u.pn * 128 + wc * 32 + 8 * fq; f32x4 v0, v1;
#pragma unroll
                for (int e = 0; e < 4; ++e) { const float g0 = acc[ai][0][m][0][e], g1 = acc[ai][0][m][1][e];
                    v0[e] = g0 * sigmoidf_(g0) * acc[ai][1][m][0][e]; v1[e] = g1 * sigmoidf_(g1) * acc[ai][1][m][1][e]; }
                u32x4 w; w.x = pk2c(v0[0], v0[1]); w.y = pk2c(v0[2], v0[3]); w.z = pk2c(v1[0], v1[1]); w.w = pk2c(v1[2], v1[3]);
                *(u32x4*)(Hd + row * DFF + col) = w;
            }
    }
};
}

namespace att {
constexpr int KROWB = 144, KBUF = 64 * KROWB, VBUF = 16384;
constexpr int L_K = 0, L_V = 2 * KBUF, L_WS = L_V + 2 * VBUF, L_END = L_WS + 8 * 256;
constexpr float SCALE = 0.125f, CL2 = SCALE * 1.4426950408889634f, THRS = 8.f / SCALE;
DI int crow(int r, int hi) { return (r & 3) + 8 * (r >> 2) + 4 * hi; }
DI unsigned cvtpk(float lo, float hi) { unsigned r; asm volatile("v_cvt_pk_bf16_f32 %0, %1, %2" : "=v"(r) : "v"(lo), "v"(hi)); return r; }
template <int DV> DI int v_st(int k, int c) { constexpr int NCB = DV / 32; const int kk = (k & ~0xC) | ((k & 4) << 1) | ((k & 8) >> 1); return ((kk >> 3) * NCB + (c >> 5)) * 512 + ((kk & 7) * 32 + (c & 31)) * 2; }
DI int v_rd_base(int lane) { return ((lane & 3) << 3) | (((lane >> 2) & 3) << 6) | (((lane >> 4) & 1) << 5) | (((lane >> 5) & 1) << 8); }
template <int DV> constexpr int v_rd_off(int d0, int ks, int half) { return d0 * 512 + (ks * 2 + half) * (DV / 32) * 512; }
template <int OFF> DI s16x4 tr_read(int vb) { s16x4 r; asm volatile("ds_read_b64_tr_b16 %0, %1 offset:%2" : "=&v"(r) : "v"(vb), "i"(OFF) : "memory"); return r; }
template <int DV, int D0> DI void pv_one(f32x16& od, int vb, bf16x8 pa0, bf16x8 pa1, bf16x8 pa2, bf16x8 pa3) {
    const s16x4 l0 = tr_read<v_rd_off<DV>(D0, 0, 0)>(vb), h0 = tr_read<v_rd_off<DV>(D0, 0, 1)>(vb), l1 = tr_read<v_rd_off<DV>(D0, 1, 0)>(vb), h1 = tr_read<v_rd_off<DV>(D0, 1, 1)>(vb);
    const s16x4 l2 = tr_read<v_rd_off<DV>(D0, 2, 0)>(vb), h2 = tr_read<v_rd_off<DV>(D0, 2, 1)>(vb), l3 = tr_read<v_rd_off<DV>(D0, 3, 0)>(vb), h3 = tr_read<v_rd_off<DV>(D0, 3, 1)>(vb);
    asm volatile("s_waitcnt lgkmcnt(0)" ::: "memory"); __builtin_amdgcn_sched_barrier(0);
#define ATT_PK(L, H) (bf16x8){L[0], L[1], L[2], L[3], H[0], H[1], H[2], H[3]}
    od = __builtin_amdgcn_mfma_f32_32x32x16_bf16(pa0, ATT_PK(l0, h0), od, 0, 0, 0);
    od = __builtin_amdgcn_mfma_f32_32x32x16_bf16(pa1, ATT_PK(l1, h1), od, 0, 0, 0);
    od = __builtin_amdgcn_mfma_f32_32x32x16_bf16(pa2, ATT_PK(l2, h2), od, 0, 0, 0);
    od = __builtin_amdgcn_mfma_f32_32x32x16_bf16(pa3, ATT_PK(l3, h3), od, 0, 0, 0);
#undef ATT_PK
}
struct TileList { int a0, na, b0, nb; };

template <int DV, bool MASK>
DI void attn_pass(LAS unsigned char* lds, const bf16_t* __restrict__ Zb, size_t qoff, int kcol, int vcol, const TileList tl, int jq, int qpos0, float m_init, float l_init, f32x16 (&o)[DV / 32], float& l_out) {
    constexpr int NCB = DV / 32;
    int tid_ = threadIdx.x; asm volatile("" : "+v"(tid_));
    const int tid = tid_, wid = tid >> 6, lane = tid & 63, r32 = lane & 31, hi = lane >> 5;
    LAS unsigned char* Kl = lds + L_K; LAS unsigned char* Vl = lds + L_V; LAS float* wsf = (LAS float*)(lds + L_WS) + wid * 64;
    bf16x8 qr[4];
#pragma unroll
    for (int d0 = 0; d0 < 4; ++d0) qr[d0] = *(const bf16x8*)(Zb + qoff + (size_t)r32 * ZLD + d0 * 16 + hi * 8);
    const int krow_t = tid >> 3, kch = tid & 7;
    const size_t kg = (size_t)krow_t * ZLD + kcol + kch * 8; const int kl = krow_t * KROWB + kch * 16;
    const int sr = (DV == 128) ? (tid >> 4) : (tid >> 3), sc = (DV == 128) ? (tid & 15) * 8 : (tid & 7) * 8;
    const size_t vg0 = (size_t)sr * ZLD + vcol + sc, vg1 = (size_t)(32 + sr) * ZLD + vcol + sc;
    const int vl0 = v_st<DV>(sr, sc), vl1 = v_st<DV>(32 + sr, sc);
    const int vb0 = (int)(uintptr_t)Vl + v_rd_base(lane);
    const int NT = tl.na + tl.nb;
#define ATT_TILE(j) ((j) < tl.na ? tl.a0 + (j) : tl.b0 + ((j) - tl.na))
    bf16x8 ks, vs0, vs1 = {};
#define ATT_GLOAD(j) do { const bf16_t* tb_ = Zb + (size_t)ATT_TILE(j) * 64 * ZLD; ks = *(const bf16x8*)(tb_ + kg); vs0 = *(const bf16x8*)(tb_ + vg0); if (DV == 128) vs1 = *(const bf16x8*)(tb_ + vg1); } while (0)
#define ATT_SWRITE(b) do { *(LAS bf16x8*)(Kl + (b) * KBUF + kl) = ks; *(LAS bf16x8*)(Vl + (b) * VBUF + vl0) = vs0; if (DV == 128) *(LAS bf16x8*)(Vl + (b) * VBUF + vl1) = vs1; } while (0)
    float m_reg = m_init, l_reg = l_init;
#pragma unroll
    for (int d = 0; d < NCB; ++d)
#pragma unroll
        for (int r = 0; r < 16; ++r) o[d][r] = 0.f;
    ATT_GLOAD(0); ATT_SWRITE(0); if (NT > 1) ATT_GLOAD(1);
    __syncthreads();
    for (int j = 0; j < NT; ++j) {
        const int cur = j & 1;
        if (j + 1 < NT) ATT_SWRITE(cur ^ 1);
        if (j + 2 < NT) ATT_GLOAD(j + 2);
        const LAS unsigned char* Kb = Kl + cur * KBUF;
        f32x16 p0, p1;
#pragma unroll
        for (int r = 0; r < 16; ++r) { p0[r] = 0.f; p1[r] = 0.f; }
#pragma unroll
        for (int d0 = 0; d0 < 4; ++d0) { const int cb = d0 * 32 + hi * 16;
            const bf16x8 b0 = *(const LAS bf16x8*)(Kb + r32 * KROWB + cb), b1 = *(const LAS bf16x8*)(Kb + (32 + r32) * KROWB + cb);
            p0 = __builtin_amdgcn_mfma_f32_32x32x16_bf16(b0, qr[d0], p0, 0, 0, 0);
            p1 = __builtin_amdgcn_mfma_f32_32x32x16_bf16(b1, qr[d0], p1, 0, 0, 0); }
        if (MASK) { const int t = ATT_TILE(j);
            if (j >= tl.na && (t == jq - 2 || t == jq + 2)) { const int dq = t * 64 - qpos0 - r32;
#pragma unroll
                for (int r = 0; r < 16; ++r) { const int d0_ = dq + crow(r, hi), d1_ = d0_ + 32;
                    if (d0_ > 128 || d0_ < -128) p0[r] = -1e30f; if (d1_ > 128 || d1_ < -128) p1[r] = -1e30f; } } }
        float pmax = p0[0];
#pragma unroll
        for (int r = 1; r < 16; ++r) pmax = fmaxf(pmax, p0[r]);
#pragma unroll
        for (int r = 0; r < 16; ++r) pmax = fmaxf(pmax, p1[r]);
        { auto rr = __builtin_amdgcn_permlane32_swap(__float_as_uint(pmax), __float_as_uint(pmax), false, false); pmax = fmaxf(__uint_as_float(rr[0]), __uint_as_float(rr[1])); }
        float mn, alpha;
        if (__all(pmax - m_reg <= THRS)) { mn = m_reg; alpha = 1.f; }
        else { mn = fmaxf(m_reg, pmax); alpha = __builtin_amdgcn_exp2f((m_reg - mn) * CL2); m_reg = mn; }
        const float mnC = -mn * CL2;
#pragma unroll
        for (int r = 0; r < 16; ++r) { p0[r] = __builtin_amdgcn_exp2f(fmaf(p0[r], CL2, mnC)); p1[r] = __builtin_amdgcn_exp2f(fmaf(p1[r], CL2, mnC)); }
        float ps = 0.f;
#pragma unroll
        for (int r = 0; r < 16; ++r) ps += p0[r] + p1[r];
        { auto rr = __builtin_amdgcn_permlane32_swap(__float_as_uint(ps), __float_as_uint(ps), false, false); ps = __uint_as_float(rr[0]) + __uint_as_float(rr[1]); }
        l_reg = l_reg * alpha + ps;
        if (__any(alpha < 1.f)) {
            if (hi == 0) wsf[r32] = alpha;
            asm volatile("s_waitcnt lgkmcnt(0)" ::: "memory");
#pragma unroll
            for (int r = 0; r < 16; ++r) { const float a = wsf[crow(r, hi)];
#pragma unroll
                for (int d = 0; d < NCB; ++d) o[d][r] *= a; }
        }
        bf16x8 pa0, pa1, pa2, pa3;
#define ATT_PK4(P, BASE, OUT) do { unsigned a0 = cvtpk(P[BASE + 0], P[BASE + 1]), a1 = cvtpk(P[BASE + 2], P[BASE + 3]); \
        unsigned b0_ = cvtpk(P[BASE + 4], P[BASE + 5]), b1_ = cvtpk(P[BASE + 6], P[BASE + 7]); \
        auto r0 = __builtin_amdgcn_permlane32_swap(a0, b0_, false, false); auto r1 = __builtin_amdgcn_permlane32_swap(a1, b1_, false, false); \
        u32x4 w = {r0[0], r1[0], r0[1], r1[1]}; OUT = __builtin_bit_cast(bf16x8, w); } while (0)
        ATT_PK4(p0, 0, pa0); ATT_PK4(p0, 8, pa1); ATT_PK4(p1, 0, pa2); ATT_PK4(p1, 8, pa3);
#undef ATT_PK4
        const int vb = vb0 + cur * VBUF;
        pv_one<DV, 0>(o[0], vb, pa0, pa1, pa2, pa3); pv_one<DV, 1>(o[1], vb, pa0, pa1, pa2, pa3);
        if constexpr (DV == 128) { pv_one<DV, 2>(o[2], vb, pa0, pa1, pa2, pa3); pv_one<DV, 3>(o[3], vb, pa0, pa1, pa2, pa3); }
        __syncthreads();
    }
    l_out = l_reg;
#undef ATT_TILE
#undef ATT_GLOAD
#undef ATT_SWRITE
}
DI void partialSM(f32x16& p0, f32x16& p1, float& m_reg, float& mn, float& alpha) {
    float pmax = p0[0];
#pragma unroll
    for (int r = 1; r < 16; ++r) pmax = fmaxf(pmax, p0[r]);
#pragma unroll
    for (int r = 0; r < 16; ++r) pmax = fmaxf(pmax, p1[r]);
    { auto rr = __builtin_amdgcn_permlane32_swap(__float_as_uint(pmax), __float_as_uint(pmax), false, false); pmax = fmaxf(__uint_as_float(rr[0]), __uint_as_float(rr[1])); }
    if (__builtin_expect(__all(pmax - m_reg <= THRS), 1)) { mn = m_reg; alpha = 1.f; }
    else { mn = fmaxf(m_reg, pmax); alpha = __builtin_amdgcn_exp2f((m_reg - mn) * CL2); m_reg = mn; }
    const float mnC = -mn * CL2;
#pragma unroll
    for (int r = 0; r < 16; ++r) p0[r] = fmaf(p0[r], CL2, mnC);
#pragma unroll
    for (int r = 0; r < 16; ++r) p1[r] = fmaf(p1[r], CL2, mnC);
#pragma unroll
    for (int r = 0; r < 16; ++r) p0[r] = __builtin_amdgcn_exp2f(p0[r]);
}
DI void finishSM(f32x16& p0, f32x16& p1, float alpha, float& l_reg, bf16x8& pa0, bf16x8& pa1, bf16x8& pa2, bf16x8& pa3) {
#pragma unroll
    for (int r = 0; r < 16; ++r) p1[r] = __builtin_amdgcn_exp2f(p1[r]);
    float ps = 0.f;
#pragma unroll
    for (int r = 0; r < 16; ++r) ps += p0[r];
#pragma unroll
    for (int r = 0; r < 16; ++r) ps += p1[r];
    { auto rr = __builtin_amdgcn_permlane32_swap(__float_as_uint(ps), __float_as_uint(ps), false, false); ps = __uint_as_float(rr[0]) + __uint_as_float(rr[1]); }
    l_reg = l_reg * alpha + ps;
#define ATT_PK4(P, BASE, OUT) do { unsigned a0 = cvtpk(P[BASE + 0], P[BASE + 1]), a1 = cvtpk(P[BASE + 2], P[BASE + 3]); \
    unsigned b0_ = cvtpk(P[BASE + 4], P[BASE + 5]), b1_ = cvtpk(P[BASE + 6], P[BASE + 7]); \
    auto r0 = __builtin_amdgcn_permlane32_swap(a0, b0_, false, false); auto r1 = __builtin_amdgcn_permlane32_swap(a1, b1_, false, false); \
    u32x4 w = {r0[0], r1[0], r0[1], r1[1]}; OUT = __builtin_bit_cast(bf16x8, w); } while (0)
    ATT_PK4(p0, 0, pa0); ATT_PK4(p0, 8, pa1); ATT_PK4(p1, 0, pa2); ATT_PK4(p1, 8, pa3);
#undef ATT_PK4
}
DI void qkt64(f32x16& p0, f32x16& p1, const LAS unsigned char* Kb, const bf16x8 (&qr)[4], int r32, int hi) {
#pragma unroll
    for (int r = 0; r < 16; ++r) { p0[r] = 0.f; p1[r] = 0.f; }
#pragma unroll
    for (int d0 = 0; d0 < 4; ++d0) { const int cb = d0 * 32 + hi * 16;
        const bf16x8 b0 = *(const LAS bf16x8*)(Kb + r32 * KROWB + cb), b1 = *(const LAS bf16x8*)(Kb + (32 + r32) * KROWB + cb);
        p0 = __builtin_amdgcn_mfma_f32_32x32x16_bf16(b0, qr[d0], p0, 0, 0, 0);
        p1 = __builtin_amdgcn_mfma_f32_32x32x16_bf16(b1, qr[d0], p1, 0, 0, 0); }
}
DI void pv128(f32x16 (&o)[4], int vb, bf16x8 pa0, bf16x8 pa1, bf16x8 pa2, bf16x8 pa3) {
    pv_one<128, 0>(o[0], vb, pa0, pa1, pa2, pa3); pv_one<128, 1>(o[1], vb, pa0, pa1, pa2, pa3); pv_one<128, 2>(o[2], vb, pa0, pa1, pa2, pa3); pv_one<128, 3>(o[3], vb, pa0, pa1, pa2, pa3);
}
struct PassDesc { const bf16_t* Zb; size_t qoff; int kcol, vcol, t0; };
struct PassRegs { bf16x8 qr[4]; bf16x8 ksE, v0E, v1E, ksO, v0O, v1O; };
DI void attn_pass_pipe(LAS unsigned char* lds, const PassDesc P, int NT, f32x16 (&o)[4], float& l_out, PassRegs& R, bool pre, bool has_next, const PassDesc N) {
    const bf16_t* __restrict__ Zb = P.Zb; const size_t qoff = P.qoff; const int kcol = P.kcol, vcol = P.vcol, t0 = P.t0;
    int tid_ = threadIdx.x; asm volatile("" : "+v"(tid_));
    const int tid = tid_, wid = tid >> 6, lane = tid & 63, r32 = lane & 31, hi = lane >> 5;
    LAS unsigned char* Kl = lds + L_K; LAS unsigned char* Vl = lds + L_V; LAS float* wsf = (LAS float*)(lds + L_WS) + wid * 64;
    bf16x8 (&qr)[4] = R.qr;
    if (!pre) {
#pragma unroll
        for (int d0 = 0; d0 < 4; ++d0) qr[d0] = *(const bf16x8*)(Zb + qoff + (size_t)r32 * ZLD + d0 * 16 + hi * 8);
    }
    const int krow_t = tid >> 3, kch = tid & 7;
    const bf16_t* kgp = Zb + (size_t)t0 * 64 * ZLD + (size_t)krow_t * ZLD + kcol + kch * 8; const int kl = krow_t * KROWB + kch * 16;
    const int sr = tid >> 4, sc = (tid & 15) * 8;
    const bf16_t* vgp0 = Zb + (size_t)t0 * 64 * ZLD + (size_t)sr * ZLD + vcol + sc; const bf16_t* vgp1 = vgp0 + (size_t)32 * ZLD;
    const int vl0 = v_st<128>(sr, sc), vl1 = v_st<128>(32 + sr, sc);
    const int vb0 = (int)(uintptr_t)Vl + v_rd_base(lane);
    constexpr size_t TSTEP = (size_t)64 * ZLD;
    bf16x8 &ksE = R.ksE, &v0E = R.v0E, &v1E = R.v1E, &ksO = R.ksO, &v0O = R.v0O, &v1O = R.v1O;
#define PP_LOADE(j) do { ksE = *(const bf16x8*)(kgp + (size_t)(j) * TSTEP); v0E = *(const bf16x8*)(vgp0 + (size_t)(j) * TSTEP); v1E = *(const bf16x8*)(vgp1 + (size_t)(j) * TSTEP); } while (0)
#define PP_LOADO(j) do { ksO = *(const bf16x8*)(kgp + (size_t)(j) * TSTEP); v0O = *(const bf16x8*)(vgp0 + (size_t)(j) * TSTEP); v1O = *(const bf16x8*)(vgp1 + (size_t)(j) * TSTEP); } while (0)
#define PP_WRITEE() do { *(LAS bf16x8*)(Kl + kl) = ksE; *(LAS bf16x8*)(Vl + vl0) = v0E; *(LAS bf16x8*)(Vl + vl1) = v1E; } while (0)
#define PP_WRITEO() do { *(LAS bf16x8*)(Kl + KBUF + kl) = ksO; *(LAS bf16x8*)(Vl + VBUF + vl0) = v0O; *(LAS bf16x8*)(Vl + VBUF + vl1) = v1O; } while (0)
#define PP_RESC(a) do { if (__any((a) < 1.f)) { if (hi == 0) wsf[r32] = (a); asm volatile("s_waitcnt lgkmcnt(0)" ::: "memory"); \
    _Pragma("unroll") for (int r = 0; r < 16; ++r) { const float a_ = wsf[crow(r, hi)]; _Pragma("unroll") for (int d = 0; d < 4; ++d) o[d][r] *= a_; } } } while (0)
#define PP_SB() __builtin_amdgcn_sched_barrier(0)
    float m_reg = -1e30f, l_reg = 0.f;
#pragma unroll
    for (int d = 0; d < 4; ++d)
#pragma unroll
        for (int r = 0; r < 16; ++r) o[d][r] = 0.f;
    f32x16 pA0, pA1, pB0, pB1; float mnA, mnB, alA, alB; bf16x8 pa0, pa1, pa2, pa3;
    if (__builtin_amdgcn_readfirstlane(wid) >= 4) __builtin_amdgcn_s_setprio(1);
    if (!pre) PP_LOADE(0);
    PP_WRITEE(); __syncthreads();
    qkt64(pA0, pA1, Kl, qr, r32, hi); partialSM(pA0, pA1, m_reg, mnA, alA);
    if (!pre) PP_LOADO(1);
    PP_LOADE(2);
    PP_WRITEO(); __syncthreads();
    for (int j = 1; j + 1 < NT; j += 2) {
        PP_SB(); qkt64(pB0, pB1, Kl + KBUF, qr, r32, hi);
        finishSM(pA0, pA1, alA, l_reg, pa0, pa1, pa2, pa3); PP_SB();
        PP_LOADO(j + 2); PP_SB();
        pv128(o, vb0, pa0, pa1, pa2, pa3); partialSM(pB0, pB1, m_reg, mnB, alB);
        __syncthreads(); PP_WRITEE();
        PP_RESC(alB); __syncthreads();
        PP_SB(); qkt64(pA0, pA1, Kl, qr, r32, hi);
        finishSM(pB0, pB1, alB, l_reg, pa0, pa1, pa2, pa3); PP_SB();
        if (j + 3 < NT) PP_LOADE(j + 3); PP_SB();
        pv128(o, vb0 + VBUF, pa0, pa1, pa2, pa3); partialSM(pA0, pA1, m_reg, mnA, alA);
        __syncthreads(); PP_WRITEO();
        PP_RESC(alA); __syncthreads();
    }
    PP_SB(); qkt64(pB0, pB1, Kl + KBUF, qr, r32, hi);
    finishSM(pA0, pA1, alA, l_reg, pa0, pa1, pa2, pa3); PP_SB();
    if (has_next) {
        const bf16_t* nk = N.Zb + (size_t)N.t0 * 64 * ZLD + (size_t)krow_t * ZLD + N.kcol + kch * 8;
        const bf16_t* nv0 = N.Zb + (size_t)N.t0 * 64 * ZLD + (size_t)sr * ZLD + N.vcol + sc; const bf16_t* nv1 = nv0 + (size_t)32 * ZLD;
#pragma unroll
        for (int d0 = 0; d0 < 4; ++d0) qr[d0] = *(const bf16x8*)(N.Zb + N.qoff + (size_t)r32 * ZLD + d0 * 16 + hi * 8);
        ksE = *(const bf16x8*)nk; v0E = *(const bf16x8*)nv0; v1E = *(const bf16x8*)nv1;
        ksO = *(const bf16x8*)(nk + TSTEP); v0O = *(const bf16x8*)(nv0 + TSTEP); v1O = *(const bf16x8*)(nv1 + TSTEP);
    }
    PP_SB();
    pv128(o, vb0, pa0, pa1, pa2, pa3); partialSM(pB0, pB1, m_reg, mnB, alB);
    __syncthreads(); PP_RESC(alB);
    finishSM(pB0, pB1, alB, l_reg, pa0, pa1, pa2, pa3); PP_SB();
    pv128(o, vb0 + VBUF, pa0, pa1, pa2, pa3);
    __builtin_amdgcn_s_setprio(0);
    __syncthreads();
    l_out = l_reg;
#undef PP_LOADE
#undef PP_LOADO
#undef PP_WRITEE
#undef PP_WRITEO
#undef PP_RESC
#undef PP_SB
}
DI void row_rcp(LAS unsigned char* lds, float l, float (&rli)[16]) {
    int tid_ = threadIdx.x; asm volatile("" : "+v"(tid_));
    const int tid = tid_, wid = tid >> 6, lane = tid & 63, r32 = lane & 31, hi = lane >> 5;
    LAS float* wsf = (LAS float*)(lds + L_WS) + wid * 64;
    if (hi == 0) wsf[32 + r32] = l;
    asm volatile("s_waitcnt lgkmcnt(0)" ::: "memory");
#pragma unroll
    for (int r = 0; r < 16; ++r) rli[r] = __builtin_amdgcn_rcpf(wsf[32 + crow(r, hi)]);
}
}

DI void transpose_item(const float* __restrict__ W, int N, bf16_t* WT, int ldt, int koff, int item, int nblk, bool ffnmap, LAS float* scr, int lane) {
    const int kb = item / nblk, nb = item % nblk, k0 = 64 * kb, n0 = 32 * nb;
#pragma unroll 8
    for (int i = 0; i < 32; ++i) { const int kk = 2 * i + (lane >> 5); scr[kk * 33 + (lane & 31)] = W[(size_t)(k0 + kk) * N + n0 + (lane & 31)]; }
    asm volatile("s_waitcnt lgkmcnt(0)" ::: "memory");
    const int c = lane & 7;
#pragma unroll
    for (int j = 0; j < 4; ++j) { const int n = (lane >> 3) + 8 * j; const LAS float* s = scr + (8 * c) * 33 + n;
        u32x4 o; o.x = pk2(s[0 * 33], s[1 * 33]); o.y = pk2(s[2 * 33], s[3 * 33]); o.z = pk2(s[4 * 33], s[5 * 33]); o.w = pk2(s[6 * 33], s[7 * 33]);
        int drow = n0 + n;
        if (ffnmap) { drow = (drow < DFF) ? ((drow >> 7) * 256 + (drow & 127)) : ((((drow - DFF) >> 7) * 256) + 128 + ((drow - DFF) & 127)); }
        *(u32x4*)(WT + (size_t)drow * ldt + koff + k0 + 8 * c) = o; }
    asm volatile("s_waitcnt lgkmcnt(0)" ::: "memory");
}

DI void conv_weights(const Cx& a, int l, LAS unsigned char* lds, int tid, int gw, int NGW, int p_lo, int p_hi) {
    const int lane = tid & 63, wave = tid >> 6;
    LAS float* scr = (LAS float*)(lds + wave * 8704);
    unsigned char* wb = a.ws + wb_off(l);
    const float* w_in = a.inp(7) + (size_t)l * DM * INW; const float* w_br = a.inp(13) + (size_t)l * 3 * 512 * DM; const float* w_o = a.inp(14) + (size_t)l * DM * DM;
    const float* w_fi = a.inp(15) + (size_t)l * DM * 2 * DFF; const float* w_fo = a.inp(16) + (size_t)l * DFF * DM;
    constexpr int I_IN = (DM / 64) * (INW / 32), I_B = (512 / 64) * (DM / 32), I_O = (DM / 64) * (DM / 32), I_FI = (DM / 64) * (2 * DFF / 32), I_FO = (DFF / 64) * (DM / 32);
    constexpr int NITEMS = I_IN + 2 * I_B + I_O + I_FI + I_FO;
    const int np = p_hi - p_lo;
    for (int jt = gw; jt < (NITEMS / 8) * np; jt += NGW) {
        const int it = (jt / np) * 8 + p_lo + jt % np; int r = it;
        if (r < I_IN) { transpose_item(w_in, INW, (bf16_t*)(wb + WB_IN), DM, 0, r, INW / 32, false, scr, lane); continue; } r -= I_IN;
        if (r < I_B) { transpose_item(w_br, DM, (bf16_t*)(wb + WB_BR), 1536, 0, r, DM / 32, false, scr, lane); continue; } r -= I_B;
        if (r < I_B) { transpose_item(w_br + (size_t)2 * 512 * DM, DM, (bf16_t*)(wb + WB_BR), 1536, 1024, r, DM / 32, false, scr, lane); continue; } r -= I_B;
        if (r < I_O) { transpose_item(w_o, DM, (bf16_t*)(wb + WB_O), DM, 0, r, DM / 32, false, scr, lane); continue; } r -= I_O;
        if (r < I_FI) { transpose_item(w_fi, 2 * DFF, (bf16_t*)(wb + WB_FI), DM, 0, r, 2 * DFF / 32, true, scr, lane); continue; } r -= I_FI;
        transpose_item(w_fo, DM, (bf16_t*)(wb + WB_FO), DFF, 0, r, DM / 32, false, scr, lane);
    }
    const float* wp = a.inp(10) + (size_t)l * 4 * 128 * 128; const float* psc = a.inp(11) + (size_t)l * 512; const float* wb1 = w_br + (size_t)512 * DM;
    bf16_t* WbT = (bf16_t*)(wb + WB_BR);
    for (int jt = gw; jt < (512 * (DM / 64) / 8) * np; jt += NGW) { const int it = (jt / np) * 8 + p_lo + jt % np;
        const int kc = it >> 4, n = (it & 15) * 64 + lane, g = kc >> 7; const float* wrow = wp + (size_t)kc * 128; const float* pss = psc + g * 128; const float* wbc = wb1 + (size_t)(g * 128) * DM + n;
        float s0 = 0.f, s1 = 0.f, s2 = 0.f, s3 = 0.f;
#pragma unroll 4
        for (int d = 0; d < 128; d += 4) {
            s0 += wrow[d] * pss[d] * wbc[(size_t)d * DM]; s1 += wrow[d + 1] * pss[d + 1] * wbc[(size_t)(d + 1) * DM];
            s2 += wrow[d + 2] * pss[d + 2] * wbc[(size_t)(d + 2) * DM]; s3 += wrow[d + 3] * pss[d + 3] * wbc[(size_t)(d + 3) * DM]; }
        WbT[(size_t)n * 1536 + 512 + kc] = (bf16_t)f2bf((s0 + s1) + (s2 + s3));
    }
}

DI void rowpass(const Cx& a, int mode, int l, int tid, int gw, int NGW) {
    const int lane = tid & 63;
    const float* MOD = (const float*)(a.ws + WS_MOD); const float* SS = (const float*)(a.ws + WS_SS); bf16_t* H = (bf16_t*)(a.ws + WS_H); float* XC = (float*)(a.ws + WS_XC);
    const float* normg = a.inp(6); const float* xin = a.inp(0); const float* cin = a.inp(2);
    const int chunk = (ROWS + NGW - 1) / NGW; const int r0 = gw * chunk; const int r1 = (r0 + chunk < ROWS) ? r0 + chunk : ROWS;
    if (r0 >= r1) return;
    const bool last = (mode == 2 && l == DEPTH - 1);
    const bool skipc = (mode != 0 && l == DEPTH - 1);
    const int l2 = (mode == 2) ? l + 1 : l; const int k2 = (mode == 1) ? 2 : 0;
    f32x4 gnv[4], g2v[4], gtv[4], shv[4], scv[4];
#pragma unroll
    for (int j = 0; j < 4; ++j) { const int c = 4 * lane + 256 * j;
        gnv[j] = (mode == 0) ? (f32x4){0.f, 0.f, 0.f, 0.f} : *(const f32x4*)(normg + ((size_t)l * 4 + (mode == 1 ? 1 : 3)) * DM + c);
        g2v[j] = last ? (f32x4){0.f, 0.f, 0.f, 0.f} : *(const f32x4*)(normg + ((size_t)l2 * 4 + k2) * DM + c);
        gtv[j] = (f32x4){0.f, 0.f, 0.f, 0.f}; shv[j] = gtv[j]; scv[j] = gtv[j]; }
    int cur_mv = -1;
    f32x4 xc[4], xn[4]; u32x2 yc[4], yn[4]; float sc_ = 0.f, sn_ = 0.f;
#define RP_XPTR(row, P) do { const int b_ = (row) / NB, n_ = (row) - b_ * NB; P = (n_ < SEQ) ? a.out + ((size_t)b_ * SEQ + n_) * DM : XC + ((size_t)b_ * CTXL + (n_ - SEQ)) * DM; } while (0)
#define RP_LOAD(row, X, Y, S_) do { const int b_ = (row) / NB, n_ = (row) - b_ * NB; \
        const float* sp_ = (mode == 0) ? ((n_ < SEQ) ? xin + ((size_t)b_ * SEQ + n_) * DM : cin + ((size_t)b_ * CTXL + (n_ - SEQ)) * DM) \
                                       : ((n_ < SEQ) ? a.out + ((size_t)b_ * SEQ + n_) * DM : XC + ((size_t)b_ * CTXL + (n_ - SEQ)) * DM); \
        _Pragma("unroll") for (int j = 0; j < 4; ++j) { X[j] = *(const f32x4*)(sp_ + 4 * lane + 256 * j); if (mode != 0) Y[j] = *(const u32x2*)(H + (size_t)(row) * DM + 4 * lane + 256 * j); } \
        if (mode != 0) S_ = SS[(size_t)(row) * 16 + (lane & 15)]; } while (0)
    RP_LOAD(r0, xc, yc, sc_);
    for (int row = r0; row < r1; ++row) {
        if (row + 1 < r1) RP_LOAD(row + 1, xn, yn, sn_);
        const int b = row / NB, n = row - b * NB; const bool lat = n < SEQ; const int mv = lat ? b : 16;
        if (!(skipc && !lat)) {
            if (mv != cur_mv) { cur_mv = mv;
                const float* mb = MOD + ((size_t)l * NMOD + mv) * MODW; const float* mb2 = MOD + ((size_t)l2 * NMOD + mv) * MODW;
#pragma unroll
                for (int j = 0; j < 4; ++j) { const int c = 4 * lane + 256 * j;
                    if (mode != 0) gtv[j] = *(const f32x4*)(mb + (mode == 1 ? 2 * DM : 5 * DM) + c);
                    if (!last) { shv[j] = *(const f32x4*)(mb2 + (mode == 1 ? 3 * DM : 0) + c); scv[j] = *(const f32x4*)(mb2 + (mode == 1 ? 4 * DM : DM) + c); } } }
            float* xp; RP_XPTR(row, xp);
            f32x4 v[4];
            if (mode == 0) {
#pragma unroll
                for (int j = 0; j < 4; ++j) { v[j] = xc[j]; *(f32x4*)(xp + 4 * lane + 256 * j) = v[j]; }
            } else {
                float ss = sc_;
                ss += __shfl_xor(ss, 1); ss += __shfl_xor(ss, 2); ss += __shfl_xor(ss, 4); ss += __shfl_xor(ss, 8);
                const float rstd = rsqrtf(ss * (1.f / DM) + EPS);
#pragma unroll
                for (int j = 0; j < 4; ++j) { f32x4 y; y[0] = bflo(yc[j].x); y[1] = bfhi(yc[j].x); y[2] = bflo(yc[j].y); y[3] = bfhi(yc[j].y);
                    v[j] = xc[j] + gtv[j] * (y * rstd * gnv[j]);
                    *(f32x4*)(xp + 4 * lane + 256 * j) = v[j]; }
            }
            if (!last) {
                float s2 = 0.f;
#pragma unroll
                for (int j = 0; j < 4; ++j) s2 += (v[j][0] * v[j][0] + v[j][1] * v[j][1]) + (v[j][2] * v[j][2] + v[j][3] * v[j][3]);
                const float rinv = rsqrtf(wave_sum(s2) * (1.f / DM) + EPS);
#pragma unroll
                for (int j = 0; j < 4; ++j) { const f32x4 h = v[j] * rinv * g2v[j] * (1.f + scv[j]) + shv[j]; u32x2 w; w.x = pk2c(h[0], h[1]); w.y = pk2c(h[2], h[3]);
                    *(u32x2*)(H + (size_t)row * DM + 4 * lane + 256 * j) = w; }
            }
        }
#pragma unroll
        for (int j = 0; j < 4; ++j) { xc[j] = xn[j]; yc[j] = yn[j]; }
        sc_ = sn_;
    }
#undef RP_XPTR
#undef RP_LOAD
}

DI att::PassDesc da_desc(bf16_t* Z, int u, int N_DA_L, int wave, int s) {
    int b, h, qb;
    if (u < N_DA_L) { b = u >> 6; h = (u >> 4) & 3; qb = u & 15; } else { const int c = u - N_DA_L; b = c >> 2; h = c & 3; qb = 16; }
    att::PassDesc d; d.Zb = Z + (size_t)b * NB * ZLD; d.qoff = (size_t)(qb * 256 + wave * 32) * ZLD + ZC_QA + h * 128 + s * 64; d.kcol = ZC_KA + h * 128 + s * 64; d.vcol = ZC_VA + h * 128; d.t0 = (qb < 16) ? 0 : 64;
    return d;
}
DI void da_unit(const Cx& a, LAS unsigned char* lds, int l, int u, int N_DA_L, att::PassRegs& R, bool pre, int un) {
    int tid_ = threadIdx.x; asm volatile("" : "+v"(tid_));
    const int tid = tid_, lane = tid & 63, wave = tid >> 6, r32 = lane & 31, hi = lane >> 5;
    bf16_t* Z = (bf16_t*)(a.ws + WS_Z); bf16_t* H = (bf16_t*)(a.ws + WS_H);
    const float lam = ((const float*)(a.ws + WS_LAM))[l]; const float lam_init = 0.8f - 0.6f * expf(-0.3f * (float)l);
    int b, h, qb;
    if (u < N_DA_L) { b = u >> 6; h = (u >> 4) & 3; qb = u & 15; } else { const int c = u - N_DA_L; b = c >> 2; h = c & 3; qb = 16; }
    const int q0 = qb * 256 + wave * 32; const int NT = (qb < 16) ? 68 : 4;
    const att::PassDesc d0 = da_desc(Z, u, N_DA_L, wave, 0), d1 = da_desc(Z, u, N_DA_L, wave, 1), dn = da_desc(Z, un >= 0 ? un : u, N_DA_L, wave, 0);
    float* stash = (float*)((unsigned char*)H + ((size_t)a.bx * 256 + wave * 32) * (DM * 2) + 1024);
    f32x16 o[4]; float lsum; float rli[16];
    att::attn_pass_pipe(lds, d0, NT, o, lsum, R, pre, true, d1);
    att::row_rcp(lds, lsum, rli);
#pragma unroll
    for (int r = 0; r < 16; ++r)
#pragma unroll
        for (int d = 0; d < 4; ++d) stash[att::crow(r, hi) * 512 + d * 32 + r32] = o[d][r] * rli[r];
    att::attn_pass_pipe(lds, d1, NT, o, lsum, R, true, un >= 0, dn);
    att::row_rcp(lds, lsum, rli);
    const float* gsub = a.inp(9) + l * 128; const float g0 = gsub[r32], g1 = gsub[32 + r32], g2 = gsub[64 + r32], g3 = gsub[96 + r32]; const float post = 1.f - lam_init;
#pragma unroll
    for (int r = 0; r < 16; ++r) { const int rr = att::crow(r, hi); float v[4]; float sq = 0.f;
#pragma unroll
        for (int d = 0; d < 4; ++d) { v[d] = stash[rr * 512 + d * 32 + r32] - lam * (o[d][r] * rli[r]); sq += v[d] * v[d]; }
        sq += __shfl_xor(sq, 1); sq += __shfl_xor(sq, 2); sq += __shfl_xor(sq, 4); sq += __shfl_xor(sq, 8); sq += __shfl_xor(sq, 16);
        const float rn = rsqrtf(sq * (1.f / 128.f) + EPS) * post;
        bf16_t* op = Z + ((size_t)b * NB + q0 + rr) * ZLD + ZC_QA + h * 128 + r32;
        op[0] = (bf16_t)f2bf(v[0] * rn * g0); op[32] = (bf16_t)f2bf(v[1] * rn * g1); op[64] = (bf16_t)f2bf(v[2] * rn * g2); op[96] = (bf16_t)f2bf(v[3] * rn * g3); }
}
DI void wa_unit(const Cx& a, LAS unsigned char* lds, int l, int c, int NJ) {
    int tid_ = threadIdx.x; asm volatile("" : "+v"(tid_));
    const int tid = tid_, lane = tid & 63, wave = tid >> 6, r32 = lane & 31, hi = lane >> 5;
    bf16_t* Z = (bf16_t*)(a.ws + WS_Z);
    const int b = c / (2 * NJ), rem = c - b * (2 * NJ), kvh = rem / NJ, jq = rem - kvh * NJ;
    const bf16_t* Zb = Z + (size_t)b * NB * ZLD;
    const int head = kvh * 4 + (wave >> 1), q0 = jq * 64 + (wave & 1) * 32;
    att::TileList tl; tl.a0 = 64; tl.na = 4;
    if (jq < 64) { const int lo = jq - 2 < 0 ? 0 : jq - 2, hi_t = jq + 2 > 63 ? 63 : jq + 2; tl.b0 = lo; tl.nb = hi_t - lo + 1; } else { tl.b0 = 0; tl.nb = 0; }
    const float sink = a.inp(12)[l * 8 + head];
    f32x16 o[2]; float lsum; float rli[16];
    att::attn_pass<64, true>(lds, Zb, (size_t)q0 * ZLD + ZC_QW + head * 64, ZC_KW + kvh * 64, ZC_VW + kvh * 64, tl, jq, q0, sink * (1.f / att::SCALE), 1.f, o, lsum);
    att::row_rcp(lds, lsum, rli);
#pragma unroll
    for (int r = 0; r < 16; ++r) { bf16_t* op = Z + ((size_t)b * NB + q0 + att::crow(r, hi)) * ZLD + ZC_QW + head * 64 + r32;
        op[0] = (bf16_t)f2bf(o[0][r] * rli[r]); op[32] = (bf16_t)f2bf(o[1][r] * rli[r]); }
}
DI void pool_rows(const Cx& a, int l, int tid, int gw, int NGW) {
    const int lane = tid & 63;
    bf16_t* Z = (bf16_t*)(a.ws + WS_Z);
    const int chunk = (ROWS + NGW - 1) / NGW; const int r0 = gw * chunk; const int r1 = (r0 + chunk < ROWS) ? r0 + chunk : ROWS;
    if (r0 >= r1) return;
    const int g = lane >> 4, hw = 1 << g;
    const bf16_t* ucol = Z + ZC_U + lane * 8;
    float sum[8];
#pragma unroll
    for (int e = 0; e < 8; ++e) sum[e] = 0.f;
#define PL_LOAD(row, WA_, WR_, WS_) do { const int b_ = (row) / NB, n_ = (row) - b_ * NB; const bool lat_ = n_ < SEQ; const int t_ = lat_ ? n_ : n_ - SEQ, ns_ = lat_ ? SEQ : CTXL; const int rb_ = (row) - t_; \
        int ja_ = t_ + hw - 1; ja_ = ja_ < ns_ ? ja_ : ns_ - 1; int jr_ = t_ - 1 - hw; jr_ = jr_ < 0 ? 0 : jr_; \
        WA_ = *(const u32x4*)(ucol + (size_t)(rb_ + ja_) * ZLD); WR_ = *(const u32x4*)(ucol + (size_t)(rb_ + jr_) * ZLD); WS_ = *(const u32x4*)(ucol + (size_t)(row) * ZLD); } while (0)
#define PL_ACC(W, F) do { sum[0] += (F) * bflo(W.x); sum[1] += (F) * bfhi(W.x); sum[2] += (F) * bflo(W.y); sum[3] += (F) * bfhi(W.y); sum[4] += (F) * bflo(W.z); sum[5] += (F) * bfhi(W.z); sum[6] += (F) * bflo(W.w); sum[7] += (F) * bfhi(W.w); } while (0)
    u32x4 wa, wr, ws_, na, nr, ns;
    PL_LOAD(r0, wa, wr, ws_);
    bool need_init = true;
    for (int row = r0; row < r1; ++row) {
        if (row + 1 < r1) PL_LOAD(row + 1, na, nr, ns);
        const int b = row / NB, n = row - b * NB; const bool lat = n < SEQ; const int t = lat ? n : n - SEQ, nseq = lat ? SEQ : CTXL; const int rbase = row - t;
        if (l == DEPTH - 1 && !lat) { need_init = true; }
        else {
            const int lo = t - hw < 0 ? 0 : t - hw, hi_ = t + hw > nseq ? nseq : t + hw;
            if (need_init || t == 0) {
                need_init = false;
#pragma unroll
                for (int e = 0; e < 8; ++e) sum[e] = 0.f;
                u32x4 w[16];
#pragma unroll
                for (int jj = 0; jj < 16; ++jj) { int j = lo + jj; j = j < hi_ ? j : hi_ - 1; w[jj] = *(const u32x4*)(ucol + (size_t)(rbase + j) * ZLD); }
#pragma unroll
                for (int jj = 0; jj < 16; ++jj) { const float f = (lo + jj < hi_) ? 1.f : 0.f; PL_ACC(w[jj], f); }
            } else {
                const float fa = (t + hw - 1 < nseq) ? 1.f : 0.f, fr = (t - 1 - hw >= 0) ? -1.f : 0.f;
                PL_ACC(wa, fa); PL_ACC(wr, fr);
            }
            const float ic = 1.f / (float)(hi_ - lo);
            u32x4 o; o.x = pk2c(sum[0] * ic - bflo(ws_.x), sum[1] * ic - bfhi(ws_.x)); o.y = pk2c(sum[2] * ic - bflo(ws_.y), sum[3] * ic - bfhi(ws_.y));
            o.z = pk2c(sum[4] * ic - bflo(ws_.z), sum[5] * ic - bfhi(ws_.z)); o.w = pk2c(sum[6] * ic - bflo(ws_.w), sum[7] * ic - bfhi(ws_.w));
            *(u32x4*)(Z + (size_t)row * ZLD + ZC_PL + lane * 8) = o;
        }
        wa = na; wr = nr; ws_ = ns;
    }
#undef PL_LOAD
#undef PL_ACC
}

DI Cx make_cx(const Args& a0) {
    Cx c; GAS unsigned char* w = (GAS unsigned char*)a0.ws; GAS float* o = (GAS float*)a0.out; int G = gridDim.x, bx = blockIdx.x;
    asm volatile("" : "+s"(w), "+s"(o), "+s"(G), "+s"(bx));
    c.ws = (unsigned char*)w; c.out = (float*)o; c.G = G; c.bx = bx; c.vcu = (G % 8 == 0) ? (bx % 8) * (G / 8) + bx / 8 : bx;
    c.tab = (const float* const*)(c.ws + WS_TAB) + bx * 32;
    return c;
}
DI void phase0(const Cx& a, LAS unsigned char* lds) {
    int tid_ = threadIdx.x; asm volatile("" : "+v"(tid_));
    const int tid = tid_, lane = tid & 63, wave = tid >> 6, G = a.G, bx = a.bx;
    const int gw = a.vcu * 8 + wave, NGW = G * 8, gtid = bx * 512 + tid, NGT = G * 512;
    float* MOD = (float*)(a.ws + WS_MOD); float* ROPE = (float*)(a.ws + WS_ROPE); float* LAM = (float*)(a.ws + WS_LAM);
    LAS float* sl = (LAS float*)lds;
    LAS float* red = (LAS float*)(lds + 17 * 1024 * 4);
    const float* cvec = a.inp(1); const float* cctx = a.inp(3); const float* wada = a.inp(4); const float* bada = a.inp(5);
    bool filled = false;
    for (int it = bx; it < DEPTH * 96; it += G) {
        if (!filled) { for (int i = tid; i < NMOD * DM; i += 512) { const int v = i >> 10, k = i & 1023; const float c = (v < 16) ? cvec[v * DM + k] : cctx[k]; sl[i] = c * sigmoidf_(c); } filled = true; __syncthreads(); }
        const int l = it / 96, cb = it % 96, col = cb * 64 + lane;
        const float* wa = wada + (size_t)l * DM * MODW + col;
        float acc[NMOD];
#pragma unroll
        for (int v = 0; v < NMOD; ++v) acc[v] = 0.f;
        for (int k = wave * 128; k < wave * 128 + 128; k += 4) {
            const float w0 = wa[(size_t)k * MODW], w1 = wa[(size_t)(k + 1) * MODW], w2 = wa[(size_t)(k + 2) * MODW], w3 = wa[(size_t)(k + 3) * MODW];
#pragma unroll
            for (int v = 0; v < NMOD; ++v) { const f32x4 s = *(const LAS f32x4*)(sl + v * DM + k); acc[v] += (s[0] * w0 + s[1] * w1) + (s[2] * w2 + s[3] * w3); }
        }
#pragma unroll
        for (int v = 0; v < NMOD; ++v) red[(wave * NMOD + v) * 64 + lane] = acc[v];
        __syncthreads();
        for (int i = tid; i < NMOD * 64; i += 512) { const int v = i >> 6, ln = i & 63; float s = bada[(size_t)l * MODW + cb * 64 + ln];
#pragma unroll
            for (int w = 0; w < 8; ++w) s += red[(w * NMOD + v) * 64 + ln];
            MOD[((size_t)l * NMOD + v) * MODW + cb * 64 + ln] = s; }
        __syncthreads();
    }
    __syncthreads();
    for (int i = gtid; i < SEQ * 32; i += NGT) { const int n = i >> 5, f = i & 31; const float pos = (f < 16) ? (float)(n >> 6) : (float)(n & 63);
        const float inv = exp2f(-(float)(f & 15) * (13.287712379549449f / 16.f)); const float ang = pos * inv; ROPE[2 * i] = __cosf(ang); ROPE[2 * i + 1] = __sinf(ang); }
    if (bx == 0 && tid < DEPTH) { const float* lp = a.inp(8) + tid * 256; float s01 = 0.f, s23 = 0.f;
        for (int i = 0; i < 64; ++i) { s01 += lp[i] * lp[64 + i]; s23 += lp[128 + i] * lp[192 + i]; }
        LAM[tid] = __expf(s01) - __expf(s23) + (0.8f - 0.6f * __expf(-0.3f * (float)tid)); }
    conv_weights(a, 0, lds, tid, gw, NGW, 0, 8);
}
DI void phase_rows(const Cx& a, int mode, int l) { int tid_ = threadIdx.x; asm volatile("" : "+v"(tid_)); rowpass(a, mode, l, tid_, a.vcu * 8 + (tid_ >> 6), a.G * 8); }
DI void phase_conv(const Cx& a, int l, LAS unsigned char* lds, int p_lo, int p_hi) { int tid_ = threadIdx.x; asm volatile("" : "+v"(tid_));
    const int first = (a.G == 256) ? 64 : 0; if (a.bx < first) return;
    conv_weights(a, l, lds, tid_, (a.bx - first) * 8 + (tid_ >> 6), (a.G - first) * 8, p_lo, p_hi); }
DI void phase_attn(const Cx& a, LAS unsigned char* lds, int l) {
    constexpr int N_DA_L = NBATCH * 4 * 16, N_DA = NBATCH * 4 * 17, N_WA = NBATCH * 2 * 68;
    const bool lastl = (l == DEPTH - 1);
    { att::PassRegs R; bool pre = false; const int nu = lastl ? N_DA_L : N_DA;
      for (int u = a.vcu; u < nu; u += a.G) { const int un = (u + a.G < nu) ? u + a.G : -1; da_unit(a, lds, l, u, N_DA_L, R, pre, un); pre = (un >= 0); } }
    const int NJ = lastl ? 64 : 68;
    for (int u = a.vcu; u < NBATCH * 2 * NJ; u += a.G) wa_unit(a, lds, l, u, NJ);
}
DI void phase_pool(const Cx& a, int l) { int tid_ = threadIdx.x; asm volatile("" : "+v"(tid_)); pool_rows(a, l, tid_, a.vcu * 8 + (tid_ >> 6), a.G * 8); }
DI void phase_g1(const Cx& a, LAS unsigned char* lds, int l) {
    pg8::SchedPlain S; S.skipctx = false; S.T.init(ROWS / 256, INW / 256, a.G, a.bx); S.A = (const char*)(a.ws + WS_H); S.lda2 = DM * 2; S.B = (const char*)(a.ws + wb_off(l) + WB_IN); S.ldb2 = DM * 2;
    { int tid_ = threadIdx.x; asm volatile("" : "+v"(tid_)); const float* R = (const float*)(a.ws + WS_ROPE); LAS float* T = (LAS float*)(lds + 131072 + 1024);
      for (int e = tid_; e < 64 * 16; e += 512) { const int pos = e >> 4, f = e & 15; T[2 * e] = R[((size_t)pos * 32 + 16 + f) * 2]; T[2 * e + 1] = R[((size_t)pos * 32 + 16 + f) * 2 + 1]; }
      __syncthreads(); }
    pg8::EpiIn E{(bf16_t*)(a.ws + WS_Z), (const LAS float*)(lds + 131072 + 1024)}; pg8::gemm_phase(lds, DM * 2, DM * 2, DM / 64, S, E); }
DI void phase_g2(const Cx& a, LAS unsigned char* lds, int l) {
    pg8::SchedMerge S; S.skipctx = (l == DEPTH - 1); S.T.init(S.skipctx ? 256 : ROWS / 256, DM / 256, a.G, a.bx); S.Z = (const char*)(a.ws + WS_Z); S.H = (const char*)(a.ws + WS_H); S.Wb = (const char*)(a.ws + wb_off(l) + WB_BR);
    pg8::EpiMerge E{(bf16_t*)(a.ws + WS_Z)}; pg8::gemm_phase(lds, ZLD * 2, 1536 * 2, 512 / 64, S, E); }
DI void phase_g3(const Cx& a, LAS unsigned char* lds, int l) {
    pg8::SchedPlain S; S.skipctx = (l == DEPTH - 1); S.T.init(S.skipctx ? 256 : ROWS / 256, DM / 256, a.G, a.bx); S.A = (const char*)(a.ws + WS_Z + ZC_M * 2); S.lda2 = ZLD * 2; S.B = (const char*)(a.ws + wb_off(l) + WB_O); S.ldb2 = DM * 2;
    pg8::EpiOut E{(bf16_t*)(a.ws + WS_H), (float*)(a.ws + WS_SS)}; pg8::gemm_phase(lds, ZLD * 2, DM * 2, DM / 64, S, E); }
DI void phase_g4(const Cx& a, LAS unsigned char* lds, int l) {
    pg8::SchedPlain S; S.skipctx = (l == DEPTH - 1); S.T.init(S.skipctx ? 256 : ROWS / 256, 2 * DFF / 256, a.G, a.bx); S.A = (const char*)(a.ws + WS_H); S.lda2 = DM * 2; S.B = (const char*)(a.ws + wb_off(l) + WB_FI); S.ldb2 = DM * 2;
    pg8::EpiFfn E{(bf16_t*)(a.ws + WS_Z)}; pg8::gemm_phase(lds, DM * 2, DM * 2, DM / 64, S, E); }
DI void phase_g5(const Cx& a, LAS unsigned char* lds, int l) {
    pg8::SchedPlain S; S.skipctx = (l == DEPTH - 1); S.T.init(S.skipctx ? 256 : ROWS / 256, DM / 256, a.G, a.bx); S.T.rev = true; S.A = (const char*)(a.ws + WS_Z); S.lda2 = DFF * 2; S.B = (const char*)(a.ws + wb_off(l) + WB_FO); S.ldb2 = DFF * 2;
    pg8::EpiOut E{(bf16_t*)(a.ws + WS_H), (float*)(a.ws + WS_SS)}; pg8::gemm_phase(lds, DFF * 2, DFF * 2, DFF / 64, S, E); }

#ifndef PHM
#define PHM 0xFFFF
#endif
__global__ void __launch_bounds__(512, 2) fwd_kernel(Args a0) {
    extern __shared__ __attribute__((aligned(16))) unsigned char lds_raw[];
    LAS unsigned char* lds = (LAS unsigned char*)lds_raw;
    cg::grid_group grid = cg::this_grid();
    if (threadIdx.x == 0) {
        const float** t = (const float**)(a0.ws + WS_TAB) + blockIdx.x * 32;
        t[0] = a0.in[0]; t[1] = a0.in[1]; t[2] = a0.in[2]; t[3] = a0.in[3]; t[4] = a0.in[4]; t[5] = a0.in[5]; t[6] = a0.in[6]; t[7] = a0.in[7]; t[8] = a0.in[8];
        t[9] = a0.in[9]; t[10] = a0.in[10]; t[11] = a0.in[11]; t[12] = a0.in[12]; t[13] = a0.in[13]; t[14] = a0.in[14]; t[15] = a0.in[15]; t[16] = a0.in[16];
        __threadfence();
    }
    __syncthreads();
    volatile LAS unsigned* xst = (volatile LAS unsigned*)(lds + 131072 + 64);
    if (threadIdx.x < 2) xst[threadIdx.x] = 0u;
    if (blockIdx.x == 0) { unsigned* bw = (unsigned*)(a0.ws + WS_BAR); for (int i = threadIdx.x; i < XCD_BAR_WORDS; i += 512) bw[i] = 0u; }
    if (PHM & 1) { const Cx a = make_cx(a0); phase0(a, lds); }
    grid.sync();
    if (threadIdx.x == 0) (void)xb_add((unsigned*)(a0.ws + WS_BAR) + XB_XCNT(xb_xcc_id()), 1u);
#define GSYNC() xcd_barrier((unsigned*)(a0.ws + WS_BAR), xst)
    if (PHM & 2) { const Cx a = make_cx(a0); phase_rows(a, 0, 0); }
    GSYNC();
#pragma unroll 1
    for (int l = 0; l < DEPTH; ++l) {
        if (PHM & 4) { const Cx a = make_cx(a0); phase_g1(a, lds, l); }
        GSYNC();
        if (PHM & 8) { const Cx a = make_cx(a0); phase_attn(a, lds, l); }
        GSYNC();
        if (PHM & 2048) { const Cx a = make_cx(a0); phase_pool(a, l); }
        GSYNC();
        if (PHM & 16) { const Cx a = make_cx(a0); phase_g2(a, lds, l); if (l + 1 < DEPTH) phase_conv(a, l + 1, lds, 0, 5); }
        GSYNC();
        if (PHM & 32) { const Cx a = make_cx(a0); phase_g3(a, lds, l); }
        GSYNC();
        if (PHM & 64) { const Cx a = make_cx(a0); phase_rows(a, 1, l); }
        GSYNC();
        if (PHM & 128) { const Cx a = make_cx(a0); phase_g4(a, lds, l); }
        GSYNC();
        if (PHM & 256) { const Cx a = make_cx(a0); phase_g5(a, lds, l); if (l + 1 < DEPTH) phase_conv(a, l + 1, lds, 5, 8); }
        GSYNC();
        if (PHM & 512) { const Cx a = make_cx(a0); phase_rows(a, 2, l); }
        if (l + 1 < DEPTH) GSYNC();
    }
}

extern "C" void kernel_launch(void* const* d_in, const int* in_sizes, int n_in, void* d_out, int out_size, void* d_ws, size_t ws_size, hipStream_t stream) {
    static int grid = 0;
    if (grid == 0) {
        if (n_in != 17 || out_size != NBATCH * SEQ * DM || ws_size < WS_END) { fprintf(stderr, "kernel_launch: unexpected shapes (n_in %d out %d ws %zu, need ws >= %zu)\n", n_in, out_size, ws_size, (size_t)WS_END); grid = -1; return; }
        int dev = 0, cus = 0, per = 0;
        hipGetDevice(&dev); hipDeviceGetAttribute(&cus, hipDeviceAttributeMultiprocessorCount, dev);
        if (hipFuncSetAttribute((const void*)fwd_kernel, hipFuncAttributeMaxDynamicSharedMemorySize, LDS_BYTES) != hipSuccess) { fprintf(stderr, "kernel_launch: hipFuncSetAttribute failed\n"); grid = -1; return; }
        hipOccupancyMaxActiveBlocksPerMultiprocessor(&per, (const void*)fwd_kernel, 512, LDS_BYTES);
        (void)hipGetLastError();
        if (per < 1) { fprintf(stderr, "kernel_launch: occupancy query says %d blocks per CU\n", per); per = 1; }
        grid = cus;
        if (grid > 256) grid = 256;
    }
    if (grid < 0) return;
    Args a{};
    for (int i = 0; i < 17; ++i) a.in[i] = (const float*)d_in[i];
    a.out = (float*)d_out; a.ws = (unsigned char*)d_ws;
    void* args[] = {&a};
    hipError_t e = hipLaunchCooperativeKernel((const void*)fwd_kernel, dim3(grid), dim3(512), args, LDS_BYTES, stream);
    if (e != hipSuccess) fprintf(stderr, "kernel_launch: cooperative launch failed: %s (grid %d)\n", hipGetErrorString(e), grid);
}
```

```cpp
#include <hip/hip_runtime.h>
#include <hip/hip_cooperative_groups.h>
#include <cstdio>
#include <cstdint>
namespace cg = cooperative_groups;

#define LAS __attribute__((address_space(3)))
typedef unsigned short bf16_t;
typedef short bf16x8 __attribute__((ext_vector_type(8)));
typedef short s16x4 __attribute__((ext_vector_type(4)));
typedef float f32x4 __attribute__((ext_vector_type(4)));
typedef float f32x16 __attribute__((ext_vector_type(16)));
typedef unsigned u32x4 __attribute__((ext_vector_type(4)));
typedef unsigned u32x2 __attribute__((ext_vector_type(2)));
#define DI __device__ __forceinline__
#define GAS __attribute__((address_space(1)))

constexpr int NBATCH = 16, SEQ = 4096, CTXL = 256, NB = SEQ + CTXL  , ROWS = NBATCH * NB  ;
constexpr int DM = 1024, DEPTH = 4, INW = 5888, DFF = 2816, ZLD = INW, MODW = 6 * DM, NMOD = 17;
constexpr float EPS = 1e-6f;
constexpr int ZC_QA = 0, ZC_KA = 512, ZC_VA = 1024, ZC_U = 1536, ZC_QW = 2048, ZC_KW = 2560, ZC_VW = 2688, ZC_G = 2816, ZC_M = 1024, ZC_PL = 512;
constexpr size_t MiB = 1u << 20;
constexpr size_t WS_LAM = 0, WS_TAB = 4096, WS_BAR = 128 * 1024, WS_MOD = 1 * MiB, WS_ROPE = 3 * MiB, WS_SS = 4 * MiB, WS_WB = 9 * MiB, WS_XC = 42 * MiB, WS_H = 58 * MiB, WS_Z = 194 * MiB, WS_WB2 = 976 * MiB, WS_END = 1010 * MiB;
constexpr size_t WB_IN = 0, WB_BR = (size_t)INW * DM * 2, WB_O = WB_BR + (size_t)DM * 1536 * 2, WB_FI = WB_O + (size_t)DM * DM * 2, WB_FO = WB_FI + (size_t)2 * DFF * DM * 2, WB_END = WB_FO + (size_t)DM * DFF * 2;
static_assert(WS_WB + WB_END <= WS_XC && WS_H + (size_t)ROWS * DM * 2 <= WS_Z && WS_Z + (size_t)ROWS * ZLD * 2 <= WS_WB2 && WS_WB2 + WB_END <= WS_END, "ws map");
__device__ __forceinline__ size_t wb_off(int l) { return (l & 1) ? WS_WB2 : WS_WB; }
constexpr int LDS_BYTES = 147456;

struct Args { const float* in[17]; float* out; unsigned char* ws; };
struct Cx { unsigned char* ws; float* out; const float* const* tab; int G, bx, vcu; __device__ __forceinline__ const float* inp(int i) const { return (const float*)(const GAS float*)tab[i]; } };

DI unsigned f2bf(float f) { unsigned u = __float_as_uint(f); return (u + 0x7fffu + ((u >> 16) & 1u)) >> 16; }
DI unsigned pk2(float lo, float hi) { return f2bf(lo) | (f2bf(hi) << 16); }
DI unsigned pk2c(float lo, float hi) { unsigned r; asm("v_cvt_pk_bf16_f32 %0, %1, %2" : "=v"(r) : "v"(lo), "v"(hi)); return r; }
DI float bflo(unsigned w) { return __uint_as_float(w << 16); }
DI float bfhi(unsigned w) { return __uint_as_float(w & 0xffff0000u); }
DI float wave_sum(float v) {
#pragma unroll
    for (int o = 1; o < 64; o <<= 1) v += __shfl_xor(v, o);
    return v;
}
DI float sigmoidf_(float x) { return __builtin_amdgcn_rcpf(1.f + __expf(-x)); }


#define XB_TMO      128
#define XB_XCNT(j)  (256  + 64 * (j))
#define XB_XSUB(j)  (1280 + 64 * (j))
#define XB_XGEN(j)  (2304 + 64 * (j))
#define XB_TOP      3328
#define XB_TOPGEN   3392
#define XCD_BAR_WORDS 3456
#define XB_SPIN_CAP (1u << 18)
DI unsigned xb_ld(unsigned* p)              { return __hip_atomic_load(p, __ATOMIC_RELAXED, __HIP_MEMORY_SCOPE_AGENT); }
DI unsigned xb_add(unsigned* p, unsigned v) { return __hip_atomic_fetch_add(p, v, __ATOMIC_RELAXED, __HIP_MEMORY_SCOPE_AGENT); }
DI unsigned xb_xcc_id() { return (unsigned)__builtin_amdgcn_s_getreg((3 << 11) | 20) & 0xFu; }
#define XB_SPIN(cond, bar) do { unsigned _sp = 0; while (cond) { __builtin_amdgcn_s_sleep(1); \
    if ((++_sp & 255u) == 0u) { if (xb_ld(&(bar)[XB_TMO])) break; if (_sp > XB_SPIN_CAP) { atomicAdd(&(bar)[XB_TMO], 1u); break; } } } } while (0)
DI void xcd_barrier_complete(unsigned* bar, unsigned x, unsigned& nloc, unsigned& nx) {
    const unsigned G = gridDim.x * gridDim.y * gridDim.z;
    unsigned sum, cnt, mine, sp = 0u;
    for (;;) {
        sum = 0u; cnt = 0u; mine = 0u;
#pragma unroll
        for (unsigned j = 0; j < 16; ++j) { const unsigned c = xb_ld(&bar[XB_XCNT(j)]); sum += c; cnt += (c > 0u) ? 1u : 0u; mine = (j == x) ? c : mine; }
        if (sum == G) break;
        __builtin_amdgcn_s_sleep(1);
        if ((++sp & 255u) == 0u) { if (xb_ld(&bar[XB_TMO])) break; if (sp > XB_SPIN_CAP) { atomicAdd(&bar[XB_TMO], 1u); break; } }
    }
    nloc = mine > 0u ? mine : 1u; nx = cnt > 0u ? cnt : 1u;
}
DI void xcd_barrier(unsigned* bar, volatile LAS unsigned* st) {
    asm volatile("s_waitcnt vmcnt(0)" ::: "memory");
    __syncthreads();
    if (threadIdx.x == 0) {
        const unsigned x = xb_xcc_id();
        __builtin_amdgcn_s_waitcnt(0);
        unsigned nloc = st[0], nx = st[1];
        if (nloc == 0u) { xcd_barrier_complete(bar, x, nloc, nx); st[0] = nloc; st[1] = nx; }
        const unsigned old = xb_add(&bar[XB_XSUB(x)], 1u);
        const unsigned gen = old / nloc;
        if (old + 1u == (gen + 1u) * nloc) {
            __builtin_amdgcn_fence(__ATOMIC_RELEASE, "agent");
            asm volatile("s_waitcnt vmcnt(0)" ::: "memory");
            const unsigned og = xb_add(&bar[XB_TOP], 1u);
            const unsigned tg = og / nx;
            if (og + 1u == (tg + 1u) * nx) xb_add(&bar[XB_TOPGEN], 1u);
            else XB_SPIN(xb_ld(&bar[XB_TOPGEN]) == tg, bar);
            __builtin_amdgcn_fence(__ATOMIC_ACQUIRE, "agent");
            xb_add(&bar[XB_XGEN(x)], 1u);
            asm volatile("s_waitcnt vmcnt(0)" ::: "memory");
        } else {
            XB_SPIN(xb_ld(&bar[XB_XGEN(x)]) == gen, bar);
            __builtin_amdgcn_fence(__ATOMIC_ACQUIRE, "agent");
            asm volatile("s_waitcnt vmcnt(0)" ::: "memory");
        }
    }
    __syncthreads();
}

namespace pg8 {
constexpr int BM = 256, BK = 64, HALF = 128, HTB = HALF * BK * 2, STAGE_BYTES = 8 * HTB, NXCD = 8, WGM = 8;
DI int lds_byte(int r, int c) { const int st = (r >> 4) * 2 + (c >> 5), rr = r & 15, cc = c & 31, ob = rr * 64 + cc * 2; return st * 1024 + (ob ^ (((ob >> 9) & 1) << 5)); }
DI void stage_rc(int b, int& R, int& C) { const int st = b / 1024, sb = b % 1024, swz = sb ^ (((sb >> 9) & 1) << 5); R = (st >> 1) * 16 + swz / 64; C = (st & 1) * 32 + (swz % 64) / 2; }

DI int perm32(int rho) { const int n = rho >> 4, i = rho & 15; return 8 * (i >> 2) + 4 * n + (i & 3); }

struct Unit { const char* A; const char* B; int lda2; int pm, pn, br; };

struct TileOrder {
    int nM, nN, nwg, G, c; bool rev = false;
    DI void init(int nM_, int nN_, int G_, int c_) { nM = nM_; nN = nN_; nwg = nM * nN; G = G_; c = c_; }
    DI bool tile(int i, int& pm, int& pn) const {
        const long L = (long)i * G + c; if (L >= nwg) return false;
        int wgid = (int)L; { const int q = nwg / NXCD, r = nwg % NXCD, xcd = wgid % NXCD; int off = wgid / NXCD; if (rev) off = (xcd < r ? q : q - 1) - off; wgid = (xcd < r ? xcd * (q + 1) : r * (q + 1) + (xcd - r) * q) + off; }
        const int nig = WGM * nN, gid = wgid / nig, fm = gid * WGM, gsz = (nM - fm) < WGM ? (nM - fm) : WGM;
        pm = fm + ((wgid % nig) % gsz); pn = (wgid % nig) / gsz; return true;
    }
};
struct SchedPlain {
    TileOrder T; const char* A; int lda2; const char* B; int ldb2; bool skipctx;
    DI bool next(int i, Unit& u) const { int pm, pn; if (!T.tile(i, pm, pn)) return false; if (skipctx) pm += pm >> 4;
        u.A = A + (size_t)pm * 256 * lda2; u.B = B + (size_t)pn * 256 * ldb2; u.lda2 = lda2; u.pm = pm; u.pn = pn; u.br = 0; return true; }
};
struct SchedMerge {
    TileOrder T; const char* Z; const char* H; const char* Wb; bool skipctx;
    DI bool next(int i, Unit& u) const { const int it = i / 3, br = i - 3 * it; int pm, pn; if (!T.tile(it, pm, pn)) return false; if (skipctx) pm += pm >> 4;
        u.A = Z + (size_t)pm * 256 * (ZLD * 2) + (br == 0 ? ZC_QA * 2 : (br == 1 ? ZC_PL * 2 : ZC_QW * 2)); u.lda2 = ZLD * 2;
        u.B = Wb + (size_t)pn * 256 * (1536 * 2) + br * 1024; u.pm = pm; u.pn = pn; u.br = br; return true; }
};

template <class Epi, class Sched>
DI void gemm_phase(LAS unsigned char* lds, const int lda2, const int ldb2, const int nt, const Sched& S, const Epi& E) {
    int tid_ = threadIdx.x; asm volatile("" : "+v"(tid_));
    const int tid = tid_, wid = __builtin_amdgcn_readfirstlane(tid >> 6), lane = tid & 63, wr = wid >> 2, wc = wid & 3, fr = lane & 15, fq = lane >> 4;
    int R0, C0, R1, C1; stage_rc(tid * 16, R0, C0); stage_rc(tid * 16 + 8192, R1, C1);
    const int Rb0 = (R0 & ~31) + perm32(R0 & 31), Rb1 = (R1 & ~31) + perm32(R1 & 31);
    const unsigned vB0 = (unsigned)(Rb0 * ldb2 + C0 * 2), vB1 = (unsigned)(Rb1 * ldb2 + C1 * 2);
    const size_t kstep = (size_t)(BK * 2);
    const size_t hstepB = (size_t)HALF * ldb2;
    const unsigned ldsw = (unsigned)wid * 1024u;
    const int aoff = lds_byte(wr * 64 + fr, fq * 8), boff = lds_byte(wc * 32 + fr, fq * 8);
#define PG8_SA(b, h) (((b) * 2 + (h)) * HTB)
#define PG8_SB(b, h) ((4 + (b) * 2 + (h)) * HTB)
#define PG8_STAGE(bufoff, gbase, V0, V1) do { \
        __builtin_amdgcn_global_load_lds((const unsigned*)((const char*)(gbase) + (V0)), (LAS unsigned*)(lds + (bufoff) + ldsw), 16, 0, 0); \
        __builtin_amdgcn_global_load_lds((const unsigned*)((const char*)(gbase) + (V1)), (LAS unsigned*)(lds + (bufoff) + ldsw + 8192), 16, 0, 0); } while (0)
#define PG8_LDA(dst, b, h) do { _Pragma("unroll") for (int m = 0; m < 4; ++m) _Pragma("unroll") for (int k = 0; k < 2; ++k) dst[m][k] = *(const LAS bf16x8*)(lds + PG8_SA(b, h) + aoff + m * 2048 + k * 1024); } while (0)
#define PG8_LDB(dst, b, h) do { _Pragma("unroll") for (int n = 0; n < 2; ++n) _Pragma("unroll") for (int k = 0; k < 2; ++k) dst[n][k] = *(const LAS bf16x8*)(lds + PG8_SB(b, h) + boff + n * 2048 + k * 1024); } while (0)
#define PG8_MMA(ai, bj, At, Bt) do { __builtin_amdgcn_s_setprio(1); _Pragma("unroll") for (int m = 0; m < 4; ++m) _Pragma("unroll") for (int n = 0; n < 2; ++n) _Pragma("unroll") for (int k = 0; k < 2; ++k) \
        acc[ai][bj][m][n] = __builtin_amdgcn_mfma_f32_16x16x32_bf16(Bt[n][k], At[m][k], acc[ai][bj][m][n], 0, 0, 0); __builtin_amdgcn_s_setprio(0); } while (0)
#define PG8_WAIT_V(n) asm volatile("s_waitcnt vmcnt(" #n ")" ::: "memory")
#define PG8_WAIT_L(n) asm volatile("s_waitcnt lgkmcnt(" #n ")" ::: "memory")
#define PG8_BAR __builtin_amdgcn_s_barrier()
#define PG8_SCHED __builtin_amdgcn_sched_barrier(0)
    Unit cur, nxt; int ui = 0;
    if (!S.next(0, cur)) return;
    f32x4 acc[2][2][4][2];
#pragma unroll
    for (int a = 0; a < 2; ++a)
#pragma unroll
        for (int b = 0; b < 2; ++b)
#pragma unroll
            for (int m = 0; m < 4; ++m)
#pragma unroll
                for (int n = 0; n < 2; ++n) acc[a][b][m][n] = (f32x4){0.f, 0.f, 0.f, 0.f};
    bf16x8 At[4][2], B0[2][2], B1[2][2];
    const char* cA = cur.A; const char* cB = cur.B;
    const unsigned vA0 = (unsigned)(R0 * lda2 + C0 * 2), vA1 = (unsigned)(R1 * lda2 + C1 * 2); const size_t hstepA = (size_t)HALF * lda2;
    PG8_STAGE(PG8_SB(0, 0), cB, vB0, vB1); PG8_STAGE(PG8_SB(0, 1), cB + hstepB, vB0, vB1); PG8_STAGE(PG8_SA(0, 0), cA, vA0, vA1); PG8_STAGE(PG8_SA(0, 1), cA + hstepA, vA0, vA1);
    if (wr == 1) PG8_BAR;
    PG8_WAIT_V(2); PG8_BAR;
    PG8_STAGE(PG8_SB(1, 0), cB + kstep, vB0, vB1); PG8_STAGE(PG8_SA(1, 0), cA + kstep, vA0, vA1); PG8_STAGE(PG8_SB(1, 1), cB + hstepB + kstep, vB0, vB1);
    PG8_WAIT_V(6); PG8_BAR;
    for (;;) {
        const bool has_next = S.next(ui + 1, nxt);
        const char* nA = has_next ? nxt.A : cA; const char* nB = has_next ? nxt.B : cB;
        for (int t = 0; t < nt; t += 2) {
            const bool last = (t == nt - 2);
            const char* a1 = cA + (size_t)(t + 1) * kstep;
            const char* a2 = last ? nA : cA + (size_t)(t + 2) * kstep; const char* b2 = last ? nB : cB + (size_t)(t + 2) * kstep;
            const char* a3 = a2 + kstep; const char* b3 = b2 + kstep;
            PG8_LDB(B0, 0, 0); PG8_LDB(B1, 0, 1); PG8_SCHED; PG8_LDA(At, 0, 0); PG8_STAGE(PG8_SA(1, 1), a1 + hstepA, vA0, vA1);
            PG8_WAIT_V(8); PG8_WAIT_L(0); PG8_BAR; PG8_MMA(0, 0, At, B0); PG8_MMA(0, 1, At, B1); PG8_BAR; PG8_SCHED;
            PG8_LDA(At, 0, 1); PG8_STAGE(PG8_SB(0, 0), b2, vB0, vB1); PG8_STAGE(PG8_SB(0, 1), b2 + hstepB, vB0, vB1); PG8_STAGE(PG8_SA(0, 0), a2, vA0, vA1);
            PG8_WAIT_V(8); PG8_WAIT_L(0); PG8_BAR; PG8_MMA(1, 0, At, B0); PG8_MMA(1, 1, At, B1); PG8_BAR; PG8_SCHED;
            PG8_LDB(B0, 1, 0); PG8_LDB(B1, 1, 1); PG8_SCHED; PG8_LDA(At, 1, 0); PG8_STAGE(PG8_SA(0, 1), a2 + hstepA, vA0, vA1);
            PG8_WAIT_V(8); PG8_WAIT_L(0); PG8_BAR; PG8_MMA(0, 0, At, B0); PG8_MMA(0, 1, At, B1); PG8_BAR; PG8_SCHED;
            PG8_LDA(At, 1, 1); PG8_STAGE(PG8_SB(1, 0), b3, vB0, vB1); PG8_STAGE(PG8_SB(1, 1), b3 + hstepB, vB0, vB1); PG8_STAGE(PG8_SA(1, 0), a3, vA0, vA1);
            PG8_WAIT_V(8); PG8_WAIT_L(0); PG8_BAR; PG8_MMA(1, 0, At, B0); PG8_MMA(1, 1, At, B1); PG8_BAR; PG8_SCHED;
        }
        if (wr == 0) PG8_BAR;
        asm volatile("s_nop 7\n\ts_nop 7\n\ts_nop 3" ::: "memory");
        E(acc, cur, wr, wc, fr, fq);
        if (!has_next) break;
        if (E.reset(cur)) {
#pragma unroll
        for (int a = 0; a < 2; ++a)
#pragma unroll
            for (int b = 0; b < 2; ++b)
#pragma unroll
                for (int m = 0; m < 4; ++m)
#pragma unroll
                    for (int n = 0; n < 2; ++n) acc[a][b][m][n] = (f32x4){0.f, 0.f, 0.f, 0.f};
        }
        cur = nxt; cA = nA; cB = nB; ++ui;
        if (wr == 1) PG8_BAR;
    }
    PG8_WAIT_V(0);
    PG8_BAR;
#undef PG8_SA
#undef PG8_SB
#undef PG8_STAGE
#undef PG8_LDA
#undef PG8_LDB
#undef PG8_MMA
#undef PG8_WAIT_V
#undef PG8_WAIT_L
#undef PG8_BAR
#undef PG8_SCHED
}

typedef f32x4 AccT[2][2][4][2];
struct EpiIn {
    bf16_t* Z; const LAS float* ropeT;
    DI bool reset(const Unit&) const { return true; }
    DI void operator()(AccT& acc, const Unit& u, int wr, int wc, int fr, int fq) const {
        asm volatile("" : "+v"(fr), "+v"(fq));
        const int pn = u.pn, pmb = u.pm % 17; const bool lat = pmb != 16;
        const bool gate = pn >= 11;
        const bool ropet = lat && (pn <= 3 || (pn >= 8 && pn <= 10));
#pragma unroll
        for (int ai = 0; ai < 2; ++ai)
#pragma unroll
            for (int m = 0; m < 4; ++m) {
                const int rt = ai * 128 + wr * 64 + m * 16 + fr; const size_t row = (size_t)u.pm * 256 + rt; const int npos = pmb * 256 + rt;
#pragma unroll
                for (int bj = 0; bj < 2; ++bj) {
                    const int col = pn * 256 + bj * 128 + wc * 32 + 8 * fq; f32x4 v0 = acc[ai][bj][m][0], v1 = acc[ai][bj][m][1];
                    if (gate) {
#pragma unroll
                        for (int e = 0; e < 4; ++e) { v0[e] = sigmoidf_(v0[e]); v1[e] = sigmoidf_(v1[e]); }
                    } else if (ropet && !(pn == 10 && bj == 1)) {
                        const int i_ = (col & 63) >> 1; const int pos_ = (i_ < 16) ? (npos >> 6) : (npos & 63);
                        const LAS float* tp = ropeT + (pos_ * 16 + (i_ & 15)) * 2;
                        const f32x4 T0 = *(const LAS f32x4*)tp, T1 = *(const LAS f32x4*)(tp + 4), T2 = *(const LAS f32x4*)(tp + 8), T3 = *(const LAS f32x4*)(tp + 12);
                        f32x4 a, b;
                        a[0] = v0[0] * T0[0] - v0[1] * T0[1]; a[1] = v0[0] * T0[1] + v0[1] * T0[0]; a[2] = v0[2] * T0[2] - v0[3] * T0[3]; a[3] = v0[2] * T0[3] + v0[3] * T0[2];
                        b[0] = v1[0] * T1[0] - v1[1] * T1[1]; b[1] = v1[0] * T1[1] + v1[1] * T1[0]; b[2] = v1[2] * T1[2] - v1[3] * T1[3]; b[3] = v1[2] * T1[3] + v1[3] * T1[2];
                        v0 = a; v1 = b; (void)T2; (void)T3;
                    } else { v0 = v0 + 0.f; v1 = v1 + 0.f; }
                    u32x4 w; w.x = pk2c(v0[0], v0[1]); w.y = pk2c(v0[2], v0[3]); w.z = pk2c(v1[0], v1[1]); w.w = pk2c(v1[2], v1[3]);
                    *(u32x4*)(Z + row * ZLD + col) = w;
                }
            }
    }
};
struct EpiMerge {
    bf16_t* Z;
    DI bool reset(const Unit& u) const { return u.br == 2; }
    DI void operator()(AccT& acc, const Unit& u, int wr, int wc, int fr, int fq) const {
        asm volatile("" : "+v"(fr), "+v"(fq));
        const int br = u.br;
#pragma unroll
        for (int ai = 0; ai < 2; ++ai) {
            u32x4 ga[4][2], gb[4][2];
#pragma unroll
            for (int m = 0; m < 4; ++m) { const size_t row = (size_t)u.pm * 256 + ai * 128 + wr * 64 + m * 16 + fr;
#pragma unroll
                for (int bj = 0; bj < 2; ++bj) { const bf16_t* gp = Z + row * ZLD + ZC_G + br * 1024 + u.pn * 256 + bj * 128 + wc * 32 + 8 * fq;
                    ga[m][bj] = *(const u32x4*)gp; gb[m][bj] = (br < 2) ? *(const u32x4*)(gp + 1024) : (u32x4){0x3f803f80u, 0x3f803f80u, 0x3f803f80u, 0x3f803f80u}; } }
            __builtin_amdgcn_sched_barrier(0);
#pragma unroll
            for (int m = 0; m < 4; ++m) { const size_t row = (size_t)u.pm * 256 + ai * 128 + wr * 64 + m * 16 + fr;
#pragma unroll
                for (int bj = 0; bj < 2; ++bj) { const int col = u.pn * 256 + bj * 128 + wc * 32 + 8 * fq;
                    const u32x4 gw = ga[m][bj], hw = gb[m][bj];
                    f32x4 g0, g1;
                    g0[0] = fmaxf(bflo(gw.x), 1e-18f); g0[1] = fmaxf(bfhi(gw.x), 1e-18f); g0[2] = fmaxf(bflo(gw.y), 1e-18f); g0[3] = fmaxf(bfhi(gw.y), 1e-18f);
                    g1[0] = fmaxf(bflo(gw.z), 1e-18f); g1[1] = fmaxf(bfhi(gw.z), 1e-18f); g1[2] = fmaxf(bflo(gw.w), 1e-18f); g1[3] = fmaxf(bfhi(gw.w), 1e-18f);
                    if (br < 2) {
                        g0[0] *= __builtin_amdgcn_rcpf(fmaxf(bflo(hw.x), 1e-18f)); g0[1] *= __builtin_amdgcn_rcpf(fmaxf(bfhi(hw.x), 1e-18f));
                        g0[2] *= __builtin_amdgcn_rcpf(fmaxf(bflo(hw.y), 1e-18f)); g0[3] *= __builtin_amdgcn_rcpf(fmaxf(bfhi(hw.y), 1e-18f));
                        g1[0] *= __builtin_amdgcn_rcpf(fmaxf(bflo(hw.z), 1e-18f)); g1[1] *= __builtin_amdgcn_rcpf(fmaxf(bfhi(hw.z), 1e-18f));
                        g1[2] *= __builtin_amdgcn_rcpf(fmaxf(bflo(hw.w), 1e-18f)); g1[3] *= __builtin_amdgcn_rcpf(fmaxf(bfhi(hw.w), 1e-18f));
                        acc[ai][bj][m][0] = acc[ai][bj][m][0] * g0; acc[ai][bj][m][1] = acc[ai][bj][m][1] * g1;
                    } else {
                        const f32x4 v0 = acc[ai][bj][m][0] * g0, v1 = acc[ai][bj][m][1] * g1;
                        u32x4 w; w.x = pk2c(v0[0], v0[1]); w.y = pk2c(v0[2], v0[3]); w.z = pk2c(v1[0], v1[1]); w.w = pk2c(v1[2], v1[3]);
                        *(u32x4*)(Z + row * ZLD + ZC_M + col) = w;
                    }
                } }
            __builtin_amdgcn_sched_barrier(0);
        }
    }
};
struct EpiOut {
    bf16_t* O; float* SS;
    DI bool reset(const Unit&) const { return true; }
    DI void operator()(AccT& acc, const Unit& u, int wr, int wc, int fr, int fq) const {
        asm volatile("" : "+v"(fr), "+v"(fq));
#pragma unroll
        for (int ai = 0; ai < 2; ++ai)
#pragma unroll
            for (int m = 0; m < 4; ++m) {
                const int rt = ai * 128 + wr * 64 + m * 16 + fr; const size_t row = (size_t)u.pm * 256 + rt; float s = 0.f;
#pragma unroll
                for (int bj = 0; bj < 2; ++bj) {
                    const int col = u.pn * 256 + bj * 128 + wc * 32 + 8 * fq; const f32x4 v0 = acc[ai][bj][m][0], v1 = acc[ai][bj][m][1];
                    s += (v0[0] * v0[0] + v0[1] * v0[1]) + (v0[2] * v0[2] + v0[3] * v0[3]); s += (v1[0] * v1[0] + v1[1] * v1[1]) + (v1[2] * v1[2] + v1[3] * v1[3]);
                    u32x4 w; w.x = pk2c(v0[0], v0[1]); w.y = pk2c(v0[2], v0[3]); w.z = pk2c(v1[0], v1[1]); w.w = pk2c(v1[2], v1[3]);
                    *(u32x4*)(O + row * DM + col) = w;
                }
                s += __shfl_xor(s, 16); s += __shfl_xor(s, 32);
                if (fq == 0) SS[row * 16 + u.pn * 4 + wc] = s;
            }
    }
};
struct EpiFfn {
    bf16_t* Hd;
    DI bool reset(const Unit&) const { return true; }
    DI void operator()(AccT& acc, const Unit& u, int wr, int wc, int fr, int fq) const {
        asm volatile("" : "+v"(fr), "+v"(fq));
#pragma unroll
        for (int ai = 0; ai < 2; ++ai)
#pragma unroll
            for (int m = 0; m < 4; ++m) {
                const int rt = ai * 128 + wr * 64 + m * 16 + fr; const size_t row = (size_t)u.pm * 256 + rt;
                const int col = u.pn * 128 + wc * 32 + 8 * fq; f32x4 v0, v1;
#pragma unroll
                for (int e = 0; e < 4; ++e) { const float g0 = acc[ai][0][m][0][e], g1 = acc[ai][0][m][1][e];
                    v0[e] = g0 * sigmoidf_(g0) * acc[ai][1][m][0][e]; v1[e] = g1 * sigmoidf_(g1) * acc[ai][1][m][1][e]; }
                u32x4 w; w.x = pk2c(v0[0], v0[1]); w.y = pk2c(v0[2], v0[3]); w.z = pk2c(v1[0], v1[1]); w.w = pk2c(v1[2], v1[3]);
                *(u32x4*)(Hd + row * DFF + col) = w;
            }
    }
};
}

namespace att {
constexpr int KROWB = 144, KBUF = 64 * KROWB, VBUF = 16384;
constexpr int L_K = 0, L_V = 2 * KBUF, L_WS = L_V + 2 * VBUF, L_END = L_WS + 8 * 256;
constexpr float SCALE = 0.125f, CL2 = SCALE * 1.4426950408889634f, THRS = 8.f / SCALE;
DI int crow(int r, int hi) { return (r & 3) + 8 * (r >> 2) + 4 * hi; }
DI unsigned cvtpk(float lo, float hi) { unsigned r; asm volatile("v_cvt_pk_bf16_f32 %0, %1, %2" : "=v"(r) : "v"(lo), "v"(hi)); return r; }
template <int DV> DI int v_st(int k, int c) { constexpr int NCB = DV / 32; const int kk = (k & ~0xC) | ((k & 4) << 1) | ((k & 8) >> 1); return ((kk >> 3) * NCB + (c >> 5)) * 512 + ((kk & 7) * 32 + (c & 31)) * 2; }
DI int v_rd_base(int lane) { return ((lane & 3) << 3) | (((lane >> 2) & 3) << 6) | (((lane >> 4) & 1) << 5) | (((lane >> 5) & 1) << 8); }
template <int DV> constexpr int v_rd_off(int d0, int ks, int half) { return d0 * 512 + (ks * 2 + half) * (DV / 32) * 512; }
template <int OFF> DI s16x4 tr_read(int vb) { s16x4 r; asm volatile("ds_read_b64_tr_b16 %0, %1 offset:%2" : "=&v"(r) : "v"(vb), "i"(OFF) : "memory"); return r; }
template <int DV, int D0> DI void pv_one(f32x16& od, int vb, bf16x8 pa0, bf16x8 pa1, bf16x8 pa2, bf16x8 pa3) {
    const s16x4 l0 = tr_read<v_rd_off<DV>(D0, 0, 0)>(vb), h0 = tr_read<v_rd_off<DV>(D0, 0, 1)>(vb), l1 = tr_read<v_rd_off<DV>(D0, 1, 0)>(vb), h1 = tr_read<v_rd_off<DV>(D0, 1, 1)>(vb);
    const s16x4 l2 = tr_read<v_rd_off<DV>(D0, 2, 0)>(vb), h2 = tr_read<v_rd_off<DV>(D0, 2, 1)>(vb), l3 = tr_read<v_rd_off<DV>(D0, 3, 0)>(vb), h3 = tr_read<v_rd_off<DV>(D0, 3, 1)>(vb);
    asm volatile("s_waitcnt lgkmcnt(0)" ::: "memory"); __builtin_amdgcn_sched_barrier(0);
#define ATT_PK(L, H) (bf16x8){L[0], L[1], L[2], L[3], H[0], H[1], H[2], H[3]}
    od = __builtin_amdgcn_mfma_f32_32x32x16_bf16(pa0, ATT_PK(l0, h0), od, 0, 0, 0);
    od = __builtin_amdgcn_mfma_f32_32x32x16_bf16(pa1, ATT_PK(l1, h1), od, 0, 0, 0);
    od = __builtin_amdgcn_mfma_f32_32x32x16_bf16(pa2, ATT_PK(l2, h2), od, 0, 0, 0);
    od = __builtin_amdgcn_mfma_f32_32x32x16_bf16(pa3, ATT_PK(l3, h3), od, 0, 0, 0);
#undef ATT_PK
}
struct TileList { int a0, na, b0, nb; };

template <int DV, bool MASK>
DI void attn_pass(LAS unsigned char* lds, const bf16_t* __restrict__ Zb, size_t qoff, int kcol, int vcol, const TileList tl, int jq, int qpos0, float m_init, float l_init, f32x16 (&o)[DV / 32], float& l_out) {
    constexpr int NCB = DV / 32;
    int tid_ = threadIdx.x; asm volatile("" : "+v"(tid_));
    const int tid = tid_, wid = tid >> 6, lane = tid & 63, r32 = lane & 31, hi = lane >> 5;
    LAS unsigned char* Kl = lds + L_K; LAS unsigned char* Vl = lds + L_V; LAS float* wsf = (LAS float*)(lds + L_WS) + wid * 64;
    bf16x8 qr[4];
#pragma unroll
    for (int d0 = 0; d0 < 4; ++d0) qr[d0] = *(const bf16x8*)(Zb + qoff + (size_t)r32 * ZLD + d0 * 16 + hi * 8);
    const int krow_t = tid >> 3, kch = tid & 7;
    const size_t kg = (size_t)krow_t * ZLD + kcol + kch * 8; const int kl = krow_t * KROWB + kch * 16;
    const int sr = (DV == 128) ? (tid >> 4) : (tid >> 3), sc = (DV == 128) ? (tid & 15) * 8 : (tid & 7) * 8;
    const size_t vg0 = (size_t)sr * ZLD + vcol + sc, vg1 = (size_t)(32 + sr) * ZLD + vcol + sc;
    const int vl0 = v_st<DV>(sr, sc), vl1 = v_st<DV>(32 + sr, sc);
    const int vb0 = (int)(uintptr_t)Vl + v_rd_base(lane);
    const int NT = tl.na + tl.nb;
#define ATT_TILE(j) ((j) < tl.na ? tl.a0 + (j) : tl.b0 + ((j) - tl.na))
    bf16x8 ks, vs0, vs1 = {};
#define ATT_GLOAD(j) do { const bf16_t* tb_ = Zb + (size_t)ATT_TILE(j) * 64 * ZLD; ks = *(const bf16x8*)(tb_ + kg); vs0 = *(const bf16x8*)(tb_ + vg0); if (DV == 128) vs1 = *(const bf16x8*)(tb_ + vg1); } while (0)
#define ATT_SWRITE(b) do { *(LAS bf16x8*)(Kl + (b) * KBUF + kl) = ks; *(LAS bf16x8*)(Vl + (b) * VBUF + vl0) = vs0; if (DV == 128) *(LAS bf16x8*)(Vl + (b) * VBUF + vl1) = vs1; } while (0)
    float m_reg = m_init, l_reg = l_init;
#pragma unroll
    for (int d = 0; d < NCB; ++d)
#pragma unroll
        for (int r = 0; r < 16; ++r) o[d][r] = 0.f;
    ATT_GLOAD(0); ATT_SWRITE(0); if (NT > 1) ATT_GLOAD(1);
    __syncthreads();
    for (int j = 0; j < NT; ++j) {
        const int cur = j & 1;
        if (j + 1 < NT) ATT_SWRITE(cur ^ 1);
        if (j + 2 < NT) ATT_GLOAD(j + 2);
        const LAS unsigned char* Kb = Kl + cur * KBUF;
        f32x16 p0, p1;
#pragma unroll
        for (int r = 0; r < 16; ++r) { p0[r] = 0.f; p1[r] = 0.f; }
#pragma unroll
        for (int d0 = 0; d0 < 4; ++d0) { const int cb = d0 * 32 + hi * 16;
            const bf16x8 b0 = *(const LAS bf16x8*)(Kb + r32 * KROWB + cb), b1 = *(const LAS bf16x8*)(Kb + (32 + r32) * KROWB + cb);
            p0 = __builtin_amdgcn_mfma_f32_32x32x16_bf16(b0, qr[d0], p0, 0, 0, 0);
            p1 = __builtin_amdgcn_mfma_f32_32x32x16_bf16(b1, qr[d0], p1, 0, 0, 0); }
        if (MASK) { const int t = ATT_TILE(j);
            if (j >= tl.na && (t == jq - 2 || t == jq + 2)) { const int dq = t * 64 - qpos0 - r32;
#pragma unroll
                for (int r = 0; r < 16; ++r) { const int d0_ = dq + crow(r, hi), d1_ = d0_ + 32;
                    if (d0_ > 128 || d0_ < -128) p0[r] = -1e30f; if (d1_ > 128 || d1_ < -128) p1[r] = -1e30f; } } }
        float pmax = p0[0];
#pragma unroll
        for (int r = 1; r < 16; ++r) pmax = fmaxf(pmax, p0[r]);
#pragma unroll
        for (int r = 0; r < 16; ++r) pmax = fmaxf(pmax, p1[r]);
        { auto rr = __builtin_amdgcn_permlane32_swap(__float_as_uint(pmax), __float_as_uint(pmax), false, false); pmax = fmaxf(__uint_as_float(rr[0]), __uint_as_float(rr[1])); }
        float mn, alpha;
        if (__all(pmax - m_reg <= THRS)) { mn = m_reg; alpha = 1.f; }
        else { mn = fmaxf(m_reg, pmax); alpha = __builtin_amdgcn_exp2f((m_reg - mn) * CL2); m_reg = mn; }
        const float mnC = -mn * CL2;
#pragma unroll
        for (int r = 0; r < 16; ++r) { p0[r] = __builtin_amdgcn_exp2f(fmaf(p0[r], CL2, mnC)); p1[r] = __builtin_amdgcn_exp2f(fmaf(p1[r], CL2, mnC)); }
        float ps = 0.f;
#pragma unroll
        for (int r = 0; r < 16; ++r) ps += p0[r] + p1[r];
        { auto rr = __builtin_amdgcn_permlane32_swap(__float_as_uint(ps), __float_as_uint(ps), false, false); ps = __uint_as_float(rr[0]) + __uint_as_float(rr[1]); }
        l_reg = l_reg * alpha + ps;
        if (__any(alpha < 1.f)) {
            if (hi == 0) wsf[r32] = alpha;
            asm volatile("s_waitcnt lgkmcnt(0)" ::: "memory");
#pragma unroll
            for (int r = 0; r < 16; ++r) { const float a = wsf[crow(r, hi)];
#pragma unroll
                for (int d = 0; d < NCB; ++d) o[d][r] *= a; }
        }
        bf16x8 pa0, pa1, pa2, pa3;
#define ATT_PK4(P, BASE, OUT) do { unsigned a0 = cvtpk(P[BASE + 0], P[BASE + 1]), a1 = cvtpk(P[BASE + 2], P[BASE + 3]); \
        unsigned b0_ = cvtpk(P[BASE + 4], P[BASE + 5]), b1_ = cvtpk(P[BASE + 6], P[BASE + 7]); \
        auto r0 = __builtin_amdgcn_permlane32_swap(a0, b0_, false, false); auto r1 = __builtin_amdgcn_permlane32_swap(a1, b1_, false, false); \
        u32x4 w = {r0[0], r1[0], r0[1], r1[1]}; OUT = __builtin_bit_cast(bf16x8, w); } while (0)
        ATT_PK4(p0, 0, pa0); ATT_PK4(p0, 8, pa1); ATT_PK4(p1, 0, pa2); ATT_PK4(p1, 8, pa3);
#undef ATT_PK4
        const int vb = vb0 + cur * VBUF;
        pv_one<DV, 0>(o[0], vb, pa0, pa1, pa2, pa3); pv_one<DV, 1>(o[1], vb, pa0, pa1, pa2, pa3);
        if constexpr (DV == 128) { pv_one<DV, 2>(o[2], vb, pa0, pa1, pa2, pa3); pv_one<DV, 3>(o[3], vb, pa0, pa1, pa2, pa3); }
        __syncthreads();
    }
    l_out = l_reg;
#undef ATT_TILE
#undef ATT_GLOAD
#undef ATT_SWRITE
}
DI void partialSM(f32x16& p0, f32x16& p1, float& m_reg, float& mn, float& alpha) {
    float pmax = p0[0];
#pragma unroll
    for (int r = 1; r < 16; ++r) pmax = fmaxf(pmax, p0[r]);
#pragma unroll
    for (int r = 0; r < 16; ++r) pmax = fmaxf(pmax, p1[r]);
    { auto rr = __builtin_amdgcn_permlane32_swap(__float_as_uint(pmax), __float_as_uint(pmax), false, false); pmax = fmaxf(__uint_as_float(rr[0]), __uint_as_float(rr[1])); }
    if (__builtin_expect(__all(pmax - m_reg <= THRS), 1)) { mn = m_reg; alpha = 1.f; }
    else { mn = fmaxf(m_reg, pmax); alpha = __builtin_amdgcn_exp2f((m_reg - mn) * CL2); m_reg = mn; }
    const float mnC = -mn * CL2;
#pragma unroll
    for (int r = 0; r < 16; ++r) p0[r] = fmaf(p0[r], CL2, mnC);
#pragma unroll
    for (int r = 0; r < 16; ++r) p1[r] = fmaf(p1[r], CL2, mnC);
#pragma unroll
    for (int r = 0; r < 16; ++r) p0[r] = __builtin_amdgcn_exp2f(p0[r]);
}
DI void finishSM(f32x16& p0, f32x16& p1, float alpha, float& l_reg, bf16x8& pa0, bf16x8& pa1, bf16x8& pa2, bf16x8& pa3) {
#pragma unroll
    for (int r = 0; r < 16; ++r) p1[r] = __builtin_amdgcn_exp2f(p1[r]);
    float ps = 0.f;
#pragma unroll
    for (int r = 0; r < 16; ++r) ps += p0[r];
#pragma unroll
    for (int r = 0; r < 16; ++r) ps += p1[r];
    { auto rr = __builtin_amdgcn_permlane32_swap(__float_as_uint(ps), __float_as_uint(ps), false, false); ps = __uint_as_float(rr[0]) + __uint_as_float(rr[1]); }
    l_reg = l_reg * alpha + ps;
#define ATT_PK4(P, BASE, OUT) do { unsigned a0 = cvtpk(P[BASE + 0], P[BASE + 1]), a1 = cvtpk(P[BASE + 2], P[BASE + 3]); \
    unsigned b0_ = cvtpk(P[BASE + 4], P[BASE + 5]), b1_ = cvtpk(P[BASE + 6], P[BASE + 7]); \
    auto r0 = __builtin_amdgcn_permlane32_swap(a0, b0_, false, false); auto r1 = __builtin_amdgcn_permlane32_swap(a1, b1_, false, false); \
    u32x4 w = {r0[0], r1[0], r0[1], r1[1]}; OUT = __builtin_bit_cast(bf16x8, w); } while (0)
    ATT_PK4(p0, 0, pa0); ATT_PK4(p0, 8, pa1); ATT_PK4(p1, 0, pa2); ATT_PK4(p1, 8, pa3);
#undef ATT_PK4
}
DI void qkt64(f32x16& p0, f32x16& p1, const LAS unsigned char* Kb, const bf16x8 (&qr)[4], int r32, int hi) {
#pragma unroll
    for (int r = 0; r < 16; ++r) { p0[r] = 0.f; p1[r] = 0.f; }
#pragma unroll
    for (int d0 = 0; d0 < 4; ++d0) { const int cb = d0 * 32 + hi * 16;
        const bf16x8 b0 = *(const LAS bf16x8*)(Kb + r32 * KROWB + cb), b1 = *(const LAS bf16x8*)(Kb + (32 + r32) * KROWB + cb);
        p0 = __builtin_amdgcn_mfma_f32_32x32x16_bf16(b0, qr[d0], p0, 0, 0, 0);
        p1 = __builtin_amdgcn_mfma_f32_32x32x16_bf16(b1, qr[d0], p1, 0, 0, 0); }
}
DI void pv128(f32x16 (&o)[4], int vb, bf16x8 pa0, bf16x8 pa1, bf16x8 pa2, bf16x8 pa3) {
    pv_one<128, 0>(o[0], vb, pa0, pa1, pa2, pa3); pv_one<128, 1>(o[1], vb, pa0, pa1, pa2, pa3); pv_one<128, 2>(o[2], vb, pa0, pa1, pa2, pa3); pv_one<128, 3>(o[3], vb, pa0, pa1, pa2, pa3);
}
DI void attn_pass_pipe(LAS unsigned char* lds, const bf16_t* __restrict__ Zb, size_t qoff, int kcol, int vcol, int t0, int NT, f32x16 (&o)[4], float& l_out) {
    int tid_ = threadIdx.x; asm volatile("" : "+v"(tid_));
    const int tid = tid_, wid = tid >> 6, lane = tid & 63, r32 = lane & 31, hi = lane >> 5;
    LAS unsigned char* Kl = lds + L_K; LAS unsigned char* Vl = lds + L_V; LAS float* wsf = (LAS float*)(lds + L_WS) + wid * 64;
    bf16x8 qr[4];
#pragma unroll
    for (int d0 = 0; d0 < 4; ++d0) qr[d0] = *(const bf16x8*)(Zb + qoff + (size_t)r32 * ZLD + d0 * 16 + hi * 8);
    const int krow_t = tid >> 3, kch = tid & 7;
    const bf16_t* kgp = Zb + (size_t)t0 * 64 * ZLD + (size_t)krow_t * ZLD + kcol + kch * 8; const int kl = krow_t * KROWB + kch * 16;
    const int sr = tid >> 4, sc = (tid & 15) * 8;
    const bf16_t* vgp0 = Zb + (size_t)t0 * 64 * ZLD + (size_t)sr * ZLD + vcol + sc; const bf16_t* vgp1 = vgp0 + (size_t)32 * ZLD;
    const int vl0 = v_st<128>(sr, sc), vl1 = v_st<128>(32 + sr, sc);
    const int vb0 = (int)(uintptr_t)Vl + v_rd_base(lane);
    constexpr size_t TSTEP = (size_t)64 * ZLD;
    bf16x8 ksE, v0E, v1E, ksO, v0O, v1O;
#define PP_LOADE(j) do { ksE = *(const bf16x8*)(kgp + (size_t)(j) * TSTEP); v0E = *(const bf16x8*)(vgp0 + (size_t)(j) * TSTEP); v1E = *(const bf16x8*)(vgp1 + (size_t)(j) * TSTEP); } while (0)
#define PP_LOADO(j) do { ksO = *(const bf16x8*)(kgp + (size_t)(j) * TSTEP); v0O = *(const bf16x8*)(vgp0 + (size_t)(j) * TSTEP); v1O = *(const bf16x8*)(vgp1 + (size_t)(j) * TSTEP); } while (0)
#define PP_WRITEE() do { *(LAS bf16x8*)(Kl + kl) = ksE; *(LAS bf16x8*)(Vl + vl0) = v0E; *(LAS bf16x8*)(Vl + vl1) = v1E; } while (0)
#define PP_WRITEO() do { *(LAS bf16x8*)(Kl + KBUF + kl) = ksO; *(LAS bf16x8*)(Vl + VBUF + vl0) = v0O; *(LAS bf16x8*)(Vl + VBUF + vl1) = v1O; } while (0)
#define PP_RESC(a) do { if (__any((a) < 1.f)) { if (hi == 0) wsf[r32] = (a); asm volatile("s_waitcnt lgkmcnt(0)" ::: "memory"); \
    _Pragma("unroll") for (int r = 0; r < 16; ++r) { const float a_ = wsf[crow(r, hi)]; _Pragma("unroll") for (int d = 0; d < 4; ++d) o[d][r] *= a_; } } } while (0)
#define PP_SB() __builtin_amdgcn_sched_barrier(0)
    float m_reg = -1e30f, l_reg = 0.f;
#pragma unroll
    for (int d = 0; d < 4; ++d)
#pragma unroll
        for (int r = 0; r < 16; ++r) o[d][r] = 0.f;
    f32x16 pA0, pA1, pB0, pB1; float mnA, mnB, alA, alB; bf16x8 pa0, pa1, pa2, pa3;
    if (__builtin_amdgcn_readfirstlane(wid) >= 4) __builtin_amdgcn_s_setprio(1);
    PP_LOADE(0); PP_WRITEE(); __syncthreads();
    qkt64(pA0, pA1, Kl, qr, r32, hi); partialSM(pA0, pA1, m_reg, mnA, alA);
    PP_LOADO(1); PP_LOADE(2);
    PP_WRITEO(); __syncthreads();
    for (int j = 1; j + 1 < NT; j += 2) {
        PP_SB(); qkt64(pB0, pB1, Kl + KBUF, qr, r32, hi);
        finishSM(pA0, pA1, alA, l_reg, pa0, pa1, pa2, pa3); PP_SB();
        PP_LOADO(j + 2); PP_SB();
        pv128(o, vb0, pa0, pa1, pa2, pa3); partialSM(pB0, pB1, m_reg, mnB, alB);
        __syncthreads(); PP_WRITEE();
        PP_RESC(alB); __syncthreads();
        PP_SB(); qkt64(pA0, pA1, Kl, qr, r32, hi);
        finishSM(pB0, pB1, alB, l_reg, pa0, pa1, pa2, pa3); PP_SB();
        if (j + 3 < NT) PP_LOADE(j + 3); PP_SB();
        pv128(o, vb0 + VBUF, pa0, pa1, pa2, pa3); partialSM(pA0, pA1, m_reg, mnA, alA);
        __syncthreads(); PP_WRITEO();
        PP_RESC(alA); __syncthreads();
    }
    PP_SB(); qkt64(pB0, pB1, Kl + KBUF, qr, r32, hi);
    finishSM(pA0, pA1, alA, l_reg, pa0, pa1, pa2, pa3); PP_SB();
    pv128(o, vb0, pa0, pa1, pa2, pa3); partialSM(pB0, pB1, m_reg, mnB, alB);
    __syncthreads(); PP_RESC(alB);
    finishSM(pB0, pB1, alB, l_reg, pa0, pa1, pa2, pa3); PP_SB();
    pv128(o, vb0 + VBUF, pa0, pa1, pa2, pa3);
    __builtin_amdgcn_s_setprio(0);
    __syncthreads();
    l_out = l_reg;
#undef PP_LOADE
#undef PP_LOADO
#undef PP_WRITEE
#undef PP_WRITEO
#undef PP_RESC
#undef PP_SB
}
DI void row_rcp(LAS unsigned char* lds, float l, float (&rli)[16]) {
    int tid_ = threadIdx.x; asm volatile("" : "+v"(tid_));
    const int tid = tid_, wid = tid >> 6, lane = tid & 63, r32 = lane & 31, hi = lane >> 5;
    LAS float* wsf = (LAS float*)(lds + L_WS) + wid * 64;
    if (hi == 0) wsf[32 + r32] = l;
    asm volatile("s_waitcnt lgkmcnt(0)" ::: "memory");
#pragma unroll
    for (int r = 0; r < 16; ++r) rli[r] = __builtin_amdgcn_rcpf(wsf[32 + crow(r, hi)]);
}
}

DI void transpose_item(const float* __restrict__ W, int N, bf16_t* WT, int ldt, int koff, int item, int nblk, bool ffnmap, LAS float* scr, int lane) {
    const int kb = item / nblk, nb = item % nblk, k0 = 64 * kb, n0 = 32 * nb;
#pragma unroll 8
    for (int i = 0; i < 32; ++i) { const int kk = 2 * i + (lane >> 5); scr[kk * 33 + (lane & 31)] = W[(size_t)(k0 + kk) * N + n0 + (lane & 31)]; }
    asm volatile("s_waitcnt lgkmcnt(0)" ::: "memory");
    const int c = lane & 7;
#pragma unroll
    for (int j = 0; j < 4; ++j) { const int n = (lane >> 3) + 8 * j; const LAS float* s = scr + (8 * c) * 33 + n;
        u32x4 o; o.x = pk2(s[0 * 33], s[1 * 33]); o.y = pk2(s[2 * 33], s[3 * 33]); o.z = pk2(s[4 * 33], s[5 * 33]); o.w = pk2(s[6 * 33], s[7 * 33]);
        int drow = n0 + n;
        if (ffnmap) { drow = (drow < DFF) ? ((drow >> 7) * 256 + (drow & 127)) : ((((drow - DFF) >> 7) * 256) + 128 + ((drow - DFF) & 127)); }
        *(u32x4*)(WT + (size_t)drow * ldt + koff + k0 + 8 * c) = o; }
    asm volatile("s_waitcnt lgkmcnt(0)" ::: "memory");
}

DI void conv_weights(const Cx& a, int l, LAS unsigned char* lds, int tid, int gw, int NGW, int p_lo, int p_hi) {
    const int lane = tid & 63, wave = tid >> 6;
    LAS float* scr = (LAS float*)(lds + wave * 8704);
    unsigned char* wb = a.ws + wb_off(l);
    const float* w_in = a.inp(7) + (size_t)l * DM * INW; const float* w_br = a.inp(13) + (size_t)l * 3 * 512 * DM; const float* w_o = a.inp(14) + (size_t)l * DM * DM;
    const float* w_fi = a.inp(15) + (size_t)l * DM * 2 * DFF; const float* w_fo = a.inp(16) + (size_t)l * DFF * DM;
    constexpr int I_IN = (DM / 64) * (INW / 32), I_B = (512 / 64) * (DM / 32), I_O = (DM / 64) * (DM / 32), I_FI = (DM / 64) * (2 * DFF / 32), I_FO = (DFF / 64) * (DM / 32);
    constexpr int NITEMS = I_IN + 2 * I_B + I_O + I_FI + I_FO;
    const int np = p_hi - p_lo;
    for (int jt = gw; jt < (NITEMS / 8) * np; jt += NGW) {
        const int it = (jt / np) * 8 + p_lo + jt % np; int r = it;
        if (r < I_IN) { transpose_item(w_in, INW, (bf16_t*)(wb + WB_IN), DM, 0, r, INW / 32, false, scr, lane); continue; } r -= I_IN;
        if (r < I_B) { transpose_item(w_br, DM, (bf16_t*)(wb + WB_BR), 1536, 0, r, DM / 32, false, scr, lane); continue; } r -= I_B;
        if (r < I_B) { transpose_item(w_br + (size_t)2 * 512 * DM, DM, (bf16_t*)(wb + WB_BR), 1536, 1024, r, DM / 32, false, scr, lane); continue; } r -= I_B;
        if (r < I_O) { transpose_item(w_o, DM, (bf16_t*)(wb + WB_O), DM, 0, r, DM / 32, false, scr, lane); continue; } r -= I_O;
        if (r < I_FI) { transpose_item(w_fi, 2 * DFF, (bf16_t*)(wb + WB_FI), DM, 0, r, 2 * DFF / 32, true, scr, lane); continue; } r -= I_FI;
        transpose_item(w_fo, DM, (bf16_t*)(wb + WB_FO), DFF, 0, r, DM / 32, false, scr, lane);
    }
    const float* wp = a.inp(10) + (size_t)l * 4 * 128 * 128; const float* psc = a.inp(11) + (size_t)l * 512; const float* wb1 = w_br + (size_t)512 * DM;
    bf16_t* WbT = (bf16_t*)(wb + WB_BR);
    for (int jt = gw; jt < (512 * (DM / 64) / 8) * np; jt += NGW) { const int it = (jt / np) * 8 + p_lo + jt % np;
        const int kc = it >> 4, n = (it & 15) * 64 + lane, g = kc >> 7; const float* wrow = wp + (size_t)kc * 128; const float* pss = psc + g * 128; const float* wbc = wb1 + (size_t)(g * 128) * DM + n;
        float s0 = 0.f, s1 = 0.f, s2 = 0.f, s3 = 0.f;
#pragma unroll 4
        for (int d = 0; d < 128; d += 4) {
            s0 += wrow[d] * pss[d] * wbc[(size_t)d * DM]; s1 += wrow[d + 1] * pss[d + 1] * wbc[(size_t)(d + 1) * DM];
            s2 += wrow[d + 2] * pss[d + 2] * wbc[(size_t)(d + 2) * DM]; s3 += wrow[d + 3] * pss[d + 3] * wbc[(size_t)(d + 3) * DM]; }
        WbT[(size_t)n * 1536 + 512 + kc] = (bf16_t)f2bf((s0 + s1) + (s2 + s3));
    }
}

DI void rowpass(const Cx& a, int mode, int l, int tid, int gw, int NGW) {
    const int lane = tid & 63;
    const float* MOD = (const float*)(a.ws + WS_MOD); const float* SS = (const float*)(a.ws + WS_SS); bf16_t* H = (bf16_t*)(a.ws + WS_H);
    bf16_t* XL = (bf16_t*)a.out; bf16_t* XCb = (bf16_t*)(a.ws + WS_XC); bf16_t* XA = (bf16_t*)(a.ws + WS_Z + 400 * MiB);
    const float* normg = a.inp(6); const float* xin = a.inp(0); const float* cin = a.inp(2);
    const int chunk = (ROWS + NGW - 1) / NGW; const int r0 = gw * chunk; const int r1 = (r0 + chunk < ROWS) ? r0 + chunk : ROWS;
    if (r0 >= r1) return;
    const bool lastl = (l == DEPTH - 1);
    const bool last = (mode == 2 && lastl);
    const bool skipc = (mode != 0 && lastl);
    const int l2 = (mode == 2) ? l + 1 : l; const int k2 = (mode == 1) ? 2 : 0;
    f32x4 gnv[4], g2v[4], gtv[4], shv[4], scv[4];
#pragma unroll
    for (int j = 0; j < 4; ++j) { const int c = 4 * lane + 256 * j;
        gnv[j] = (mode == 0) ? (f32x4){0.f, 0.f, 0.f, 0.f} : *(const f32x4*)(normg + ((size_t)l * 4 + (mode == 1 ? 1 : 3)) * DM + c);
        g2v[j] = last ? (f32x4){0.f, 0.f, 0.f, 0.f} : *(const f32x4*)(normg + ((size_t)l2 * 4 + k2) * DM + c);
        gtv[j] = (f32x4){0.f, 0.f, 0.f, 0.f}; shv[j] = gtv[j]; scv[j] = gtv[j]; }
    int cur_mv = -1;
    f32x4 xfc[4], xfn[4]; u32x2 xbc[4], xbn[4]; u32x2 yc[4], yn[4]; float sc_ = 0.f, sn_ = 0.f;
#define RP_XSRC(b_, n_) ((n_) < SEQ ? ((mode == 2 && lastl) ? XA : XL) + ((size_t)(b_) * SEQ + (n_)) * DM : XCb + ((size_t)(b_) * CTXL + ((n_) - SEQ)) * DM)
#define RP_XDST(b_, n_) ((n_) < SEQ ? ((mode == 1 && lastl) ? XA : XL) + ((size_t)(b_) * SEQ + (n_)) * DM : XCb + ((size_t)(b_) * CTXL + ((n_) - SEQ)) * DM)
#define RP_LOAD(row, XF, XB, Y, S_) do { const int b_ = (row) / NB, n_ = (row) - b_ * NB; \
        if (mode == 0) { const float* sp_ = (n_ < SEQ) ? xin + ((size_t)b_ * SEQ + n_) * DM : cin + ((size_t)b_ * CTXL + (n_ - SEQ)) * DM; \
            _Pragma("unroll") for (int j = 0; j < 4; ++j) XF[j] = *(const f32x4*)(sp_ + 4 * lane + 256 * j); } \
        else { const bf16_t* sp_ = RP_XSRC(b_, n_); \
            _Pragma("unroll") for (int j = 0; j < 4; ++j) { XB[j] = *(const u32x2*)(sp_ + 4 * lane + 256 * j); Y[j] = *(const u32x2*)(H + (size_t)(row) * DM + 4 * lane + 256 * j); } \
            S_ = SS[(size_t)(row) * 16 + (lane & 15)]; } } while (0)
    RP_LOAD(r0, xfc, xbc, yc, sc_);
    for (int row = r0; row < r1; ++row) {
        if (row + 1 < r1) RP_LOAD(row + 1, xfn, xbn, yn, sn_);
        const int b = row / NB, n = row - b * NB; const bool lat = n < SEQ; const int mv = lat ? b : 16;
        if (!(skipc && !lat)) {
            if (mv != cur_mv) { cur_mv = mv;
                const float* mb = MOD + ((size_t)l * NMOD + mv) * MODW; const float* mb2 = MOD + ((size_t)l2 * NMOD + mv) * MODW;
#pragma unroll
                for (int j = 0; j < 4; ++j) { const int c = 4 * lane + 256 * j;
                    if (mode != 0) gtv[j] = *(const f32x4*)(mb + (mode == 1 ? 2 * DM : 5 * DM) + c);
                    if (!last) { shv[j] = *(const f32x4*)(mb2 + (mode == 1 ? 3 * DM : 0) + c); scv[j] = *(const f32x4*)(mb2 + (mode == 1 ? 4 * DM : DM) + c); } } }
            f32x4 v[4];
            if (mode == 0) {
#pragma unroll
                for (int j = 0; j < 4; ++j) v[j] = xfc[j];
            } else {
                float ss = sc_;
                ss += __shfl_xor(ss, 1); ss += __shfl_xor(ss, 2); ss += __shfl_xor(ss, 4); ss += __shfl_xor(ss, 8);
                const float rstd = rsqrtf(ss * (1.f / DM) + EPS);
#pragma unroll
                for (int j = 0; j < 4; ++j) { f32x4 y, x; y[0] = bflo(yc[j].x); y[1] = bfhi(yc[j].x); y[2] = bflo(yc[j].y); y[3] = bfhi(yc[j].y);
                    x[0] = bflo(xbc[j].x); x[1] = bfhi(xbc[j].x); x[2] = bflo(xbc[j].y); x[3] = bfhi(xbc[j].y);
                    v[j] = x + gtv[j] * (y * rstd * gnv[j]); }
            }
            if (last) {
                float* op = a.out + ((size_t)b * SEQ + n) * DM;
#pragma unroll
                for (int j = 0; j < 4; ++j) *(f32x4*)(op + 4 * lane + 256 * j) = v[j];
            } else {
                bf16_t* xp = RP_XDST(b, n);
#pragma unroll
                for (int j = 0; j < 4; ++j) { u32x2 w; w.x = pk2c(v[j][0], v[j][1]); w.y = pk2c(v[j][2], v[j][3]); *(u32x2*)(xp + 4 * lane + 256 * j) = w; }
                float s2 = 0.f;
#pragma unroll
                for (int j = 0; j < 4; ++j) s2 += (v[j][0] * v[j][0] + v[j][1] * v[j][1]) + (v[j][2] * v[j][2] + v[j][3] * v[j][3]);
                const float rinv = rsqrtf(wave_sum(s2) * (1.f / DM) + EPS);
#pragma unroll
                for (int j = 0; j < 4; ++j) { const f32x4 h = v[j] * rinv * g2v[j] * (1.f + scv[j]) + shv[j]; u32x2 w; w.x = pk2c(h[0], h[1]); w.y = pk2c(h[2], h[3]);
                    *(u32x2*)(H + (size_t)row * DM + 4 * lane + 256 * j) = w; }
            }
        }
#pragma unroll
        for (int j = 0; j < 4; ++j) { xfc[j] = xfn[j]; xbc[j] = xbn[j]; yc[j] = yn[j]; }
        sc_ = sn_;
    }
#undef RP_XSRC
#undef RP_XDST
#undef RP_LOAD
}

DI void da_unit(const Cx& a, LAS unsigned char* lds, int l, int u, int N_DA_L) {
    int tid_ = threadIdx.x; asm volatile("" : "+v"(tid_));
    const int tid = tid_, lane = tid & 63, wave = tid >> 6, r32 = lane & 31, hi = lane >> 5;
    bf16_t* Z = (bf16_t*)(a.ws + WS_Z); bf16_t* H = (bf16_t*)(a.ws + WS_H);
    const float lam = ((const float*)(a.ws + WS_LAM))[l]; const float lam_init = 0.8f - 0.6f * expf(-0.3f * (float)l);
    int b, h, qb;
    if (u < N_DA_L) { b = u >> 6; h = (u >> 4) & 3; qb = u & 15; } else { const int c = u - N_DA_L; b = c >> 2; h = c & 3; qb = 16; }
    const bf16_t* Zb = Z + (size_t)b * NB * ZLD;
    const int q0 = qb * 256 + wave * 32;
    att::TileList tl; tl.a0 = (qb < 16) ? 0 : 64; tl.na = (qb < 16) ? 68 : 4; tl.b0 = 0; tl.nb = 0;
    float* stash = (float*)((unsigned char*)H + ((size_t)a.bx * 256 + wave * 32) * (DM * 2) + 1024);
    f32x16 o[4]; float lsum; float rli[16];
    att::attn_pass_pipe(lds, Zb, (size_t)q0 * ZLD + ZC_QA + h * 128, ZC_KA + h * 128, ZC_VA + h * 128, tl.a0, tl.na, o, lsum);
    att::row_rcp(lds, lsum, rli);
#pragma unroll
    for (int r = 0; r < 16; ++r)
#pragma unroll
        for (int d = 0; d < 4; ++d) stash[att::crow(r, hi) * 512 + d * 32 + r32] = o[d][r] * rli[r];
    att::attn_pass_pipe(lds, Zb, (size_t)q0 * ZLD + ZC_QA + h * 128 + 64, ZC_KA + h * 128 + 64, ZC_VA + h * 128, tl.a0, tl.na, o, lsum);
    att::row_rcp(lds, lsum, rli);
    const float* gsub = a.inp(9) + l * 128; const float g0 = gsub[r32], g1 = gsub[32 + r32], g2 = gsub[64 + r32], g3 = gsub[96 + r32]; const float post = 1.f - lam_init;
#pragma unroll
    for (int r = 0; r < 16; ++r) { const int rr = att::crow(r, hi); float v[4]; float sq = 0.f;
#pragma unroll
        for (int d = 0; d < 4; ++d) { v[d] = stash[rr * 512 + d * 32 + r32] - lam * (o[d][r] * rli[r]); sq += v[d] * v[d]; }
        sq += __shfl_xor(sq, 1); sq += __shfl_xor(sq, 2); sq += __shfl_xor(sq, 4); sq += __shfl_xor(sq, 8); sq += __shfl_xor(sq, 16);
        const float rn = rsqrtf(sq * (1.f / 128.f) + EPS) * post;
        bf16_t* op = Z + ((size_t)b * NB + q0 + rr) * ZLD + ZC_QA + h * 128 + r32;
        op[0] = (bf16_t)f2bf(v[0] * rn * g0); op[32] = (bf16_t)f2bf(v[1] * rn * g1); op[64] = (bf16_t)f2bf(v[2] * rn * g2); op[96] = (bf16_t)f2bf(v[3] * rn * g3); }
}
DI void wa_unit(const Cx& a, LAS unsigned char* lds, int l, int c, int NJ) {
    int tid_ = threadIdx.x; asm volatile("" : "+v"(tid_));
    const int tid = tid_, lane = tid & 63, wave = tid >> 6, r32 = lane & 31, hi = lane >> 5;
    bf16_t* Z = (bf16_t*)(a.ws + WS_Z);
    const int b = c / (2 * NJ), rem = c - b * (2 * NJ), kvh = rem / NJ, jq = rem - kvh * NJ;
    const bf16_t* Zb = Z + (size_t)b * NB * ZLD;
    const int head = kvh * 4 + (wave >> 1), q0 = jq * 64 + (wave & 1) * 32;
    att::TileList tl; tl.a0 = 64; tl.na = 4;
    if (jq < 64) { const int lo = jq - 2 < 0 ? 0 : jq - 2, hi_t = jq + 2 > 63 ? 63 : jq + 2; tl.b0 = lo; tl.nb = hi_t - lo + 1; } else { tl.b0 = 0; tl.nb = 0; }
    const float sink = a.inp(12)[l * 8 + head];
    f32x16 o[2]; float lsum; float rli[16];
    att::attn_pass<64, true>(lds, Zb, (size_t)q0 * ZLD + ZC_QW + head * 64, ZC_KW + kvh * 64, ZC_VW + kvh * 64, tl, jq, q0, sink * (1.f / att::SCALE), 1.f, o, lsum);
    att::row_rcp(lds, lsum, rli);
#pragma unroll
    for (int r = 0; r < 16; ++r) { bf16_t* op = Z + ((size_t)b * NB + q0 + att::crow(r, hi)) * ZLD + ZC_QW + head * 64 + r32;
        op[0] = (bf16_t)f2bf(o[0][r] * rli[r]); op[32] = (bf16_t)f2bf(o[1][r] * rli[r]); }
}
DI void pool_rows(const Cx& a, int l, int tid, int gw, int NGW) {
    const int lane = tid & 63;
    bf16_t* Z = (bf16_t*)(a.ws + WS_Z);
    const int chunk = (ROWS + NGW - 1) / NGW; const int r0 = gw * chunk; const int r1 = (r0 + chunk < ROWS) ? r0 + chunk : ROWS;
    if (r0 >= r1) return;
    const int g = lane >> 4, hw = 1 << g;
    const bf16_t* ucol = Z + ZC_U + lane * 8;
    float sum[8];
#pragma unroll
    for (int e = 0; e < 8; ++e) sum[e] = 0.f;
#define PL_LOAD(row, WA_, WR_, WS_) do { const int b_ = (row) / NB, n_ = (row) - b_ * NB; const bool lat_ = n_ < SEQ; const int t_ = lat_ ? n_ : n_ - SEQ, ns_ = lat_ ? SEQ : CTXL; const int rb_ = (row) - t_; \
        int ja_ = t_ + hw - 1; ja_ = ja_ < ns_ ? ja_ : ns_ - 1; int jr_ = t_ - 1 - hw; jr_ = jr_ < 0 ? 0 : jr_; \
        WA_ = *(const u32x4*)(ucol + (size_t)(rb_ + ja_) * ZLD); WR_ = *(const u32x4*)(ucol + (size_t)(rb_ + jr_) * ZLD); WS_ = *(const u32x4*)(ucol + (size_t)(row) * ZLD); } while (0)
#define PL_ACC(W, F) do { sum[0] += (F) * bflo(W.x); sum[1] += (F) * bfhi(W.x); sum[2] += (F) * bflo(W.y); sum[3] += (F) * bfhi(W.y); sum[4] += (F) * bflo(W.z); sum[5] += (F) * bfhi(W.z); sum[6] += (F) * bflo(W.w); sum[7] += (F) * bfhi(W.w); } while (0)
    u32x4 wa, wr, ws_, na, nr, ns;
    PL_LOAD(r0, wa, wr, ws_);
    bool need_init = true;
    for (int row = r0; row < r1; ++row) {
        if (row + 1 < r1) PL_LOAD(row + 1, na, nr, ns);
        const int b = row / NB, n = row - b * NB; const bool lat = n < SEQ; const int t = lat ? n : n - SEQ, nseq = lat ? SEQ : CTXL; const int rbase = row - t;
        if (l == DEPTH - 1 && !lat) { need_init = true; }
        else {
            const int lo = t - hw < 0 ? 0 : t - hw, hi_ = t + hw > nseq ? nseq : t + hw;
            if (need_init || t == 0) {
                need_init = false;
#pragma unroll
                for (int e = 0; e < 8; ++e) sum[e] = 0.f;
                u32x4 w[16];
#pragma unroll
                for (int jj = 0; jj < 16; ++jj) { int j = lo + jj; j = j < hi_ ? j : hi_ - 1; w[jj] = *(const u32x4*)(ucol + (size_t)(rbase + j) * ZLD); }
#pragma unroll
                for (int jj = 0; jj < 16; ++jj) { const float f = (lo + jj < hi_) ? 1.f : 0.f; PL_ACC(w[jj], f); }
            } else {
                const float fa = (t + hw - 1 < nseq) ? 1.f : 0.f, fr = (t - 1 - hw >= 0) ? -1.f : 0.f;
                PL_ACC(wa, fa); PL_ACC(wr, fr);
            }
            const float ic = 1.f / (float)(hi_ - lo);
            u32x4 o; o.x = pk2c(sum[0] * ic - bflo(ws_.x), sum[1] * ic - bfhi(ws_.x)); o.y = pk2c(sum[2] * ic - bflo(ws_.y), sum[3] * ic - bfhi(ws_.y));
            o.z = pk2c(sum[4] * ic - bflo(ws_.z), sum[5] * ic - bfhi(ws_.z)); o.w = pk2c(sum[6] * ic - bflo(ws_.w), sum[7] * ic - bfhi(ws_.w));
            *(u32x4*)(Z + (size_t)row * ZLD + ZC_PL + lane * 8) = o;
        }
        wa = na; wr = nr; ws_ = ns;
    }
#undef PL_LOAD
#undef PL_ACC
}

DI Cx make_cx(const Args& a0) {
    Cx c; GAS unsigned char* w = (GAS unsigned char*)a0.ws; GAS float* o = (GAS float*)a0.out; int G = gridDim.x, bx = blockIdx.x;
    asm volatile("" : "+s"(w), "+s"(o), "+s"(G), "+s"(bx));
    c.ws = (unsigned char*)w; c.out = (float*)o; c.G = G; c.bx = bx; c.vcu = (G % 8 == 0) ? (bx % 8) * (G / 8) + bx / 8 : bx;
    c.tab = (const float* const*)(c.ws + WS_TAB) + bx * 32;
    return c;
}
DI void phase0(const Cx& a, LAS unsigned char* lds) {
    int tid_ = threadIdx.x; asm volatile("" : "+v"(tid_));
    const int tid = tid_, lane = tid & 63, wave = tid >> 6, G = a.G, bx = a.bx;
    const int gw = a.vcu * 8 + wave, NGW = G * 8, gtid = bx * 512 + tid, NGT = G * 512;
    float* MOD = (float*)(a.ws + WS_MOD); float* ROPE = (float*)(a.ws + WS_ROPE); float* LAM = (float*)(a.ws + WS_LAM);
    LAS float* sl = (LAS float*)lds;
    LAS float* red = (LAS float*)(lds + 17 * 1024 * 4);
    const float* cvec = a.inp(1); const float* cctx = a.inp(3); const float* wada = a.inp(4); const float* bada = a.inp(5);
    bool filled = false;
    for (int it = bx; it < DEPTH * 96; it += G) {
        if (!filled) { for (int i = tid; i < NMOD * DM; i += 512) { const int v = i >> 10, k = i & 1023; const float c = (v < 16) ? cvec[v * DM + k] : cctx[k]; sl[i] = c * sigmoidf_(c); } filled = true; __syncthreads(); }
        const int l = it / 96, cb = it % 96, col = cb * 64 + lane;
        const float* wa = wada + (size_t)l * DM * MODW + col;
        float acc[NMOD];
#pragma unroll
        for (int v = 0; v < NMOD; ++v) acc[v] = 0.f;
        for (int k = wave * 128; k < wave * 128 + 128; k += 4) {
            const float w0 = wa[(size_t)k * MODW], w1 = wa[(size_t)(k + 1) * MODW], w2 = wa[(size_t)(k + 2) * MODW], w3 = wa[(size_t)(k + 3) * MODW];
#pragma unroll
            for (int v = 0; v < NMOD; ++v) { const f32x4 s = *(const LAS f32x4*)(sl + v * DM + k); acc[v] += (s[0] * w0 + s[1] * w1) + (s[2] * w2 + s[3] * w3); }
        }
#pragma unroll
        for (int v = 0; v < NMOD; ++v) red[(wave * NMOD + v) * 64 + lane] = acc[v];
        __syncthreads();
        for (int i = tid; i < NMOD * 64; i += 512) { const int v = i >> 6, ln = i & 63; float s = bada[(size_t)l * MODW + cb * 64 + ln];
#pragma unroll
            for (int w = 0; w < 8; ++w) s += red[(w * NMOD + v) * 64 + ln];
            MOD[((size_t)l * NMOD + v) * MODW + cb * 64 + ln] = s; }
        __syncthreads();
    }
    __syncthreads();
    for (int i = gtid; i < SEQ * 32; i += NGT) { const int n = i >> 5, f = i & 31; const float pos = (f < 16) ? (float)(n >> 6) : (float)(n & 63);
        const float inv = exp2f(-(float)(f & 15) * (13.287712379549449f / 16.f)); const float ang = pos * inv; ROPE[2 * i] = __cosf(ang); ROPE[2 * i + 1] = __sinf(ang); }
    if (bx == 0 && tid < DEPTH) { const float* lp = a.inp(8) + tid * 256; float s01 = 0.f, s23 = 0.f;
        for (int i = 0; i < 64; ++i) { s01 += lp[i] * lp[64 + i]; s23 += lp[128 + i] * lp[192 + i]; }
        LAM[tid] = __expf(s01) - __expf(s23) + (0.8f - 0.6f * __expf(-0.3f * (float)tid)); }
    conv_weights(a, 0, lds, tid, gw, NGW, 0, 8);
}
DI void phase_rows(const Cx& a, int mode, int l) { int tid_ = threadIdx.x; asm volatile("" : "+v"(tid_)); rowpass(a, mode, l, tid_, a.vcu * 8 + (tid_ >> 6), a.G * 8); }
DI void phase_conv(const Cx& a, int l, LAS unsigned char* lds, int p_lo, int p_hi) { int tid_ = threadIdx.x; asm volatile("" : "+v"(tid_));
    const int first = (a.G == 256) ? 64 : 0; if (a.bx < first) return;
    conv_weights(a, l, lds, tid_, (a.bx - first) * 8 + (tid_ >> 6), (a.G - first) * 8, p_lo, p_hi); }
DI void phase_attn(const Cx& a, LAS unsigned char* lds, int l) {
    constexpr int N_DA_L = NBATCH * 4 * 16, N_DA = NBATCH * 4 * 17, N_WA = NBATCH * 2 * 68;
    const bool lastl = (l == DEPTH - 1);
    for (int u = a.vcu; u < (lastl ? N_DA_L : N_DA); u += a.G) da_unit(a, lds, l, u, N_DA_L);
    const int NJ = lastl ? 64 : 68;
    for (int u = a.vcu; u < NBATCH * 2 * NJ; u += a.G) wa_unit(a, lds, l, u, NJ);
}
DI void phase_pool(const Cx& a, int l) { int tid_ = threadIdx.x; asm volatile("" : "+v"(tid_)); pool_rows(a, l, tid_, a.vcu * 8 + (tid_ >> 6), a.G * 8); }
DI void phase_g1(const Cx& a, LAS unsigned char* lds, int l) {
    pg8::SchedPlain S; S.skipctx = false; S.T.init(ROWS / 256, INW / 256, a.G, a.bx); S.A = (const char*)(a.ws + WS_H); S.lda2 = DM * 2; S.B = (const char*)(a.ws + wb_off(l) + WB_IN); S.ldb2 = DM * 2;
    { int tid_ = threadIdx.x; asm volatile("" : "+v"(tid_)); const float* R = (const float*)(a.ws + WS_ROPE); LAS float* T = (LAS float*)(lds + 131072 + 1024);
      for (int e = tid_; e < 64 * 16; e += 512) { const int pos = e >> 4, f = e & 15; T[2 * e] = R[((size_t)pos * 32 + 16 + f) * 2]; T[2 * e + 1] = R[((size_t)pos * 32 + 16 + f) * 2 + 1]; }
      __syncthreads(); }
    pg8::EpiIn E{(bf16_t*)(a.ws + WS_Z), (const LAS float*)(lds + 131072 + 1024)}; pg8::gemm_phase(lds, DM * 2, DM * 2, DM / 64, S, E); }
DI void phase_g2(const Cx& a, LAS unsigned char* lds, int l) {
    pg8::SchedMerge S; S.skipctx = (l == DEPTH - 1); S.T.init(S.skipctx ? 256 : ROWS / 256, DM / 256, a.G, a.bx); S.Z = (const char*)(a.ws + WS_Z); S.H = (const char*)(a.ws + WS_H); S.Wb = (const char*)(a.ws + wb_off(l) + WB_BR);
    pg8::EpiMerge E{(bf16_t*)(a.ws + WS_Z)}; pg8::gemm_phase(lds, ZLD * 2, 1536 * 2, 512 / 64, S, E); }
DI void phase_g3(const Cx& a, LAS unsigned char* lds, int l) {
    pg8::SchedPlain S; S.skipctx = (l == DEPTH - 1); S.T.init(S.skipctx ? 256 : ROWS / 256, DM / 256, a.G, a.bx); S.A = (const char*)(a.ws + WS_Z + ZC_M * 2); S.lda2 = ZLD * 2; S.B = (const char*)(a.ws + wb_off(l) + WB_O); S.ldb2 = DM * 2;
    pg8::EpiOut E{(bf16_t*)(a.ws + WS_H), (float*)(a.ws + WS_SS)}; pg8::gemm_phase(lds, ZLD * 2, DM * 2, DM / 64, S, E); }
DI void phase_g4(const Cx& a, LAS unsigned char* lds, int l) {
    pg8::SchedPlain S; S.skipctx = (l == DEPTH - 1); S.T.init(S.skipctx ? 256 : ROWS / 256, 2 * DFF / 256, a.G, a.bx); S.A = (const char*)(a.ws + WS_H); S.lda2 = DM * 2; S.B = (const char*)(a.ws + wb_off(l) + WB_FI); S.ldb2 = DM * 2;
    pg8::EpiFfn E{(bf16_t*)(a.ws + WS_Z)}; pg8::gemm_phase(lds, DM * 2, DM * 2, DM / 64, S, E); }
DI void phase_g5(const Cx& a, LAS unsigned char* lds, int l) {
    pg8::SchedPlain S; S.skipctx = (l == DEPTH - 1); S.T.init(S.skipctx ? 256 : ROWS / 256, DM / 256, a.G, a.bx); S.T.rev = true; S.A = (const char*)(a.ws + WS_Z); S.lda2 = DFF * 2; S.B = (const char*)(a.ws + wb_off(l) + WB_FO); S.ldb2 = DFF * 2;
    pg8::EpiOut E{(bf16_t*)(a.ws + WS_H), (float*)(a.ws + WS_SS)}; pg8::gemm_phase(lds, DFF * 2, DFF * 2, DFF / 64, S, E); }

#ifndef PHM
#define PHM 0xFFFF
#endif
__global__ void __launch_bounds__(512, 2) fwd_kernel(Args a0) {
    extern __shared__ __attribute__((aligned(16))) unsigned char lds_raw[];
    LAS unsigned char* lds = (LAS unsigned char*)lds_raw;
    cg::grid_group grid = cg::this_grid();
    if (threadIdx.x == 0) {
        const float** t = (const float**)(a0.ws + WS_TAB) + blockIdx.x * 32;
        t[0] = a0.in[0]; t[1] = a0.in[1]; t[2] = a0.in[2]; t[3] = a0.in[3]; t[4] = a0.in[4]; t[5] = a0.in[5]; t[6] = a0.in[6]; t[7] = a0.in[7]; t[8] = a0.in[8];
        t[9] = a0.in[9]; t[10] = a0.in[10]; t[11] = a0.in[11]; t[12] = a0.in[12]; t[13] = a0.in[13]; t[14] = a0.in[14]; t[15] = a0.in[15]; t[16] = a0.in[16];
        __threadfence();
    }
    __syncthreads();
    volatile LAS unsigned* xst = (volatile LAS unsigned*)(lds + 131072 + 64);
    if (threadIdx.x < 2) xst[threadIdx.x] = 0u;
    if (blockIdx.x == 0) { unsigned* bw = (unsigned*)(a0.ws + WS_BAR); for (int i = threadIdx.x; i < XCD_BAR_WORDS; i += 512) bw[i] = 0u; }
    if (PHM & 1) { const Cx a = make_cx(a0); phase0(a, lds); }
    grid.sync();
    if (threadIdx.x == 0) (void)xb_add((unsigned*)(a0.ws + WS_BAR) + XB_XCNT(xb_xcc_id()), 1u);
#define GSYNC() xcd_barrier((unsigned*)(a0.ws + WS_BAR), xst)
    if (PHM & 2) { const Cx a = make_cx(a0); phase_rows(a, 0, 0); }
    GSYNC();
#pragma unroll 1
    for (int l = 0; l < DEPTH; ++l) {
        if (PHM & 4) { const Cx a = make_cx(a0); phase_g1(a, lds, l); }
        GSYNC();
        if (PHM & 8) { const Cx a = make_cx(a0); phase_attn(a, lds, l); }
        GSYNC();
        if (PHM & 2048) { const Cx a = make_cx(a0); phase_pool(a, l); }
        GSYNC();
        if (PHM & 16) { const Cx a = make_cx(a0); phase_g2(a, lds, l); if (l + 1 < DEPTH) phase_conv(a, l + 1, lds, 0, 5); }
        GSYNC();
        if (PHM & 32) { const Cx a = make_cx(a0); phase_g3(a, lds, l); }
        GSYNC();
        if (PHM & 64) { const Cx a = make_cx(a0); phase_rows(a, 1, l); }
        GSYNC();
        if (PHM & 128) { const Cx a = make_cx(a0); phase_g4(a, lds, l); }
        GSYNC();
        if (PHM & 256) { const Cx a = make_cx(a0); phase_g5(a, lds, l); if (l + 1 < DEPTH) phase_conv(a, l + 1, lds, 5, 8); }
        GSYNC();
        if (PHM & 512) { const Cx a = make_cx(a0); phase_rows(a, 2, l); }
        if (l + 1 < DEPTH) GSYNC();
    }
}

extern "C" void kernel_launch(void* const* d_in, const int* in_sizes, int n_in, void* d_out, int out_size, void* d_ws, size_t ws_size, hipStream_t stream) {
    static int grid = 0;
    if (grid == 0) {
        if (n_in != 17 || out_size != NBATCH * SEQ * DM || ws_size < WS_END) { fprintf(stderr, "kernel_launch: unexpected shapes (n_in %d out %d ws %zu, need ws >= %zu)\n", n_in, out_size, ws_size, (size_t)WS_END); grid = -1; return; }
        int dev = 0, cus = 0, per = 0;
        hipGetDevice(&dev); hipDeviceGetAttribute(&cus, hipDeviceAttributeMultiprocessorCount, dev);
        if (hipFuncSetAttribute((const void*)fwd_kernel, hipFuncAttributeMaxDynamicSharedMemorySize, LDS_BYTES) != hipSuccess) { fprintf(stderr, "kernel_launch: hipFuncSetAttribute failed\n"); grid = -1; return; }
        hipOccupancyMaxActiveBlocksPerMultiprocessor(&per, (const void*)fwd_kernel, 512, LDS_BYTES);
        (void)hipGetLastError();
        if (per < 1) { fprintf(stderr, "kernel_launch: occupancy query says %d blocks per CU\n", per); per = 1; }
        grid = cus;
        if (grid > 256) grid = 256;
    }
    if (grid < 0) return;
    Args a{};
    for (int i = 0; i < 17; ++i) a.in[i] = (const float*)d_in[i];
    a.out = (float*)d_out; a.ws = (unsigned char*)d_ws;
    void* args[] = {&a};
    hipError_t e = hipLaunchCooperativeKernel((const void*)fwd_kernel, dim3(grid), dim3(512), args, LDS_BYTES, stream);
    if (e != hipSuccess) fprintf(stderr, "kernel_launch: cooperative launch failed: %s (grid %d)\n", hipGetErrorString(e), grid);
}
```

```cpp
#include <hip/hip_runtime.h>
#include <hip/hip_cooperative_groups.h>
#include <cstdio>
#include <cstdint>
namespace cg = cooperative_groups;

#define LAS __attribute__((address_space(3)))
typedef unsigned short bf16_t;
typedef short bf16x8 __attribute__((ext_vector_type(8)));
typedef short s16x4 __attribute__((ext_vector_type(4)));
typedef float f32x4 __attribute__((ext_vector_type(4)));
typedef float f32x16 __attribute__((ext_vector_type(16)));
typedef unsigned u32x4 __attribute__((ext_vector_type(4)));
typedef unsigned u32x2 __attribute__((ext_vector_type(2)));
#define DI __device__ __forceinline__
#define GAS __attribute__((address_space(1)))

constexpr int NBATCH = 16, SEQ = 4096, CTXL = 256, NB = SEQ + CTXL  , ROWS = NBATCH * NB  ;
constexpr int DM = 1024, DEPTH = 4, INW = 5888, DFF = 2816, ZLD = INW, MODW = 6 * DM, NMOD = 17;
constexpr float EPS = 1e-6f;
constexpr int ZC_QA = 0, ZC_KA = 512, ZC_VA = 1024, ZC_U = 1536, ZC_QW = 2048, ZC_KW = 2560, ZC_VW = 2688, ZC_G = 2816, ZC_M = 1024, ZC_PL = 512;
constexpr size_t MiB = 1u << 20;
constexpr size_t WS_LAM = 0, WS_TAB = 4096, WS_BAR = 128 * 1024, WS_QCTR = 192 * 1024, WS_MOD = 1 * MiB, WS_ROPE = 3 * MiB, WS_SS = 4 * MiB, WS_WB = 9 * MiB, WS_XC = 42 * MiB, WS_H = 58 * MiB, WS_Z = 194 * MiB, WS_WB2 = 976 * MiB, WS_END = 1010 * MiB;
constexpr size_t WB_IN = 0, WB_BR = (size_t)INW * DM * 2, WB_O = WB_BR + (size_t)DM * 1536 * 2, WB_FI = WB_O + (size_t)DM * DM * 2, WB_FO = WB_FI + (size_t)2 * DFF * DM * 2, WB_END = WB_FO + (size_t)DM * DFF * 2;
static_assert(WS_WB + WB_END <= WS_XC && WS_H + (size_t)ROWS * DM * 2 <= WS_Z && WS_Z + (size_t)ROWS * ZLD * 2 <= WS_WB2 && WS_WB2 + WB_END <= WS_END, "ws map");
__device__ __forceinline__ size_t wb_off(int l) { return (l & 1) ? WS_WB2 : WS_WB; }
constexpr int LDS_BYTES = 147456;

struct Args { const float* in[17]; float* out; unsigned char* ws; };
struct Cx { unsigned char* ws; float* out; const float* const* tab; int G, bx, vcu; __device__ __forceinline__ const float* inp(int i) const { return (const float*)(const GAS float*)tab[i]; } };

DI unsigned f2bf(float f) { unsigned u = __float_as_uint(f); return (u + 0x7fffu + ((u >> 16) & 1u)) >> 16; }
DI unsigned pk2(float lo, float hi) { return f2bf(lo) | (f2bf(hi) << 16); }
DI unsigned pk2c(float lo, float hi) { unsigned r; asm("v_cvt_pk_bf16_f32 %0, %1, %2" : "=v"(r) : "v"(lo), "v"(hi)); return r; }
DI float bflo(unsigned w) { return __uint_as_float(w << 16); }
DI float bfhi(unsigned w) { return __uint_as_float(w & 0xffff0000u); }
DI float wave_sum(float v) {
#pragma unroll
    for (int o = 1; o < 64; o <<= 1) v += __shfl_xor(v, o);
    return v;
}
DI float sigmoidf_(float x) { return __builtin_amdgcn_rcpf(1.f + __expf(-x)); }


#define XB_TMO      128
#define XB_XCNT(j)  (256  + 64 * (j))
#define XB_XSUB(j)  (1280 + 64 * (j))
#define XB_XGEN(j)  (2304 + 64 * (j))
#define XB_TOP      3328
#define XB_TOPGEN   3392
#define XCD_BAR_WORDS 3456
#define XB_SPIN_CAP (1u << 18)
DI unsigned xb_ld(unsigned* p)              { return __hip_atomic_load(p, __ATOMIC_RELAXED, __HIP_MEMORY_SCOPE_AGENT); }
DI unsigned xb_add(unsigned* p, unsigned v) { return __hip_atomic_fetch_add(p, v, __ATOMIC_RELAXED, __HIP_MEMORY_SCOPE_AGENT); }
DI unsigned xb_xcc_id() { return (unsigned)__builtin_amdgcn_s_getreg((3 << 11) | 20) & 0xFu; }
#define XB_SPIN(cond, bar) do { unsigned _sp = 0; while (cond) { __builtin_amdgcn_s_sleep(1); \
    if ((++_sp & 255u) == 0u) { if (xb_ld(&(bar)[XB_TMO])) break; if (_sp > XB_SPIN_CAP) { atomicAdd(&(bar)[XB_TMO], 1u); break; } } } } while (0)
DI void xcd_barrier_complete(unsigned* bar, unsigned x, unsigned& nloc, unsigned& nx) {
    const unsigned G = gridDim.x * gridDim.y * gridDim.z;
    unsigned sum, cnt, mine, sp = 0u;
    for (;;) {
        sum = 0u; cnt = 0u; mine = 0u;
#pragma unroll
        for (unsigned j = 0; j < 16; ++j) { const unsigned c = xb_ld(&bar[XB_XCNT(j)]); sum += c; cnt += (c > 0u) ? 1u : 0u; mine = (j == x) ? c : mine; }
        if (sum == G) break;
        __builtin_amdgcn_s_sleep(1);
        if ((++sp & 255u) == 0u) { if (xb_ld(&bar[XB_TMO])) break; if (sp > XB_SPIN_CAP) { atomicAdd(&bar[XB_TMO], 1u); break; } }
    }
    nloc = mine > 0u ? mine : 1u; nx = cnt > 0u ? cnt : 1u;
}
DI void xcd_barrier(unsigned* bar, volatile LAS unsigned* st) {
    asm volatile("s_waitcnt vmcnt(0)" ::: "memory");
    __syncthreads();
    if (threadIdx.x == 0) {
        const unsigned x = xb_xcc_id();
        __builtin_amdgcn_s_waitcnt(0);
        unsigned nloc = st[0], nx = st[1];
        if (nloc == 0u) { xcd_barrier_complete(bar, x, nloc, nx); st[0] = nloc; st[1] = nx; }
        const unsigned old = xb_add(&bar[XB_XSUB(x)], 1u);
        const unsigned gen = old / nloc;
        if (old + 1u == (gen + 1u) * nloc) {
            __builtin_amdgcn_fence(__ATOMIC_RELEASE, "agent");
            asm volatile("s_waitcnt vmcnt(0)" ::: "memory");
            const unsigned og = xb_add(&bar[XB_TOP], 1u);
            const unsigned tg = og / nx;
            if (og + 1u == (tg + 1u) * nx) xb_add(&bar[XB_TOPGEN], 1u);
            else XB_SPIN(xb_ld(&bar[XB_TOPGEN]) == tg, bar);
            __builtin_amdgcn_fence(__ATOMIC_ACQUIRE, "agent");
            xb_add(&bar[XB_XGEN(x)], 1u);
            asm volatile("s_waitcnt vmcnt(0)" ::: "memory");
        } else {
            XB_SPIN(xb_ld(&bar[XB_XGEN(x)]) == gen, bar);
            __builtin_amdgcn_fence(__ATOMIC_ACQUIRE, "agent");
            asm volatile("s_waitcnt vmcnt(0)" ::: "memory");
        }
    }
    __syncthreads();
}

namespace pg8 {
constexpr int BM = 256, BK = 64, HALF = 128, HTB = HALF * BK * 2, STAGE_BYTES = 8 * HTB, NXCD = 8, WGM = 8;
DI int lds_byte(int r, int c) { const int st = (r >> 4) * 2 + (c >> 5), rr = r & 15, cc = c & 31, ob = rr * 64 + cc * 2; return st * 1024 + (ob ^ (((ob >> 9) & 1) << 5)); }
DI void stage_rc(int b, int& R, int& C) { const int st = b / 1024, sb = b % 1024, swz = sb ^ (((sb >> 9) & 1) << 5); R = (st >> 1) * 16 + swz / 64; C = (st & 1) * 32 + (swz % 64) / 2; }

DI int perm32(int rho) { const int n = rho >> 4, i = rho & 15; return 8 * (i >> 2) + 4 * n + (i & 3); }

struct Unit { const char* A; const char* B; int lda2; int pm, pn, br; };

struct TileOrder {
    int nM, nN, nwg, G, c; bool rev = false;
    DI void init(int nM_, int nN_, int G_, int c_) { nM = nM_; nN = nN_; nwg = nM * nN; G = G_; c = c_; }
    DI bool tile(int i, int& pm, int& pn) const {
        const long L = (long)i * G + c; if (L >= nwg) return false;
        int wgid = (int)L; { const int q = nwg / NXCD, r = nwg % NXCD, xcd = wgid % NXCD; int off = wgid / NXCD; if (rev) off = (xcd < r ? q : q - 1) - off; wgid = (xcd < r ? xcd * (q + 1) : r * (q + 1) + (xcd - r) * q) + off; }
        const int nig = WGM * nN, gid = wgid / nig, fm = gid * WGM, gsz = (nM - fm) < WGM ? (nM - fm) : WGM;
        pm = fm + ((wgid % nig) % gsz); pn = (wgid % nig) / gsz; return true;
    }
};
struct SchedPlain {
    TileOrder T; const char* A; int lda2; const char* B; int ldb2; bool skipctx;
    DI bool next(int i, Unit& u) const { int pm, pn; if (!T.tile(i, pm, pn)) return false; if (skipctx) pm += pm >> 4;
        u.A = A + (size_t)pm * 256 * lda2; u.B = B + (size_t)pn * 256 * ldb2; u.lda2 = lda2; u.pm = pm; u.pn = pn; u.br = 0; return true; }
};
struct SchedMerge {
    TileOrder T; const char* Z; const char* H; const char* Wb; bool skipctx;
    DI bool next(int i, Unit& u) const { const int it = i / 3, br = i - 3 * it; int pm, pn; if (!T.tile(it, pm, pn)) return false; if (skipctx) pm += pm >> 4;
        u.A = Z + (size_t)pm * 256 * (ZLD * 2) + (br == 0 ? ZC_QA * 2 : (br == 1 ? ZC_PL * 2 : ZC_QW * 2)); u.lda2 = ZLD * 2;
        u.B = Wb + (size_t)pn * 256 * (1536 * 2) + br * 1024; u.pm = pm; u.pn = pn; u.br = br; return true; }
};

template <class Epi, class Sched>
DI void gemm_phase(LAS unsigned char* lds, const int lda2, const int ldb2, const int nt, const Sched& S, const Epi& E) {
    int tid_ = threadIdx.x; asm volatile("" : "+v"(tid_));
    const int tid = tid_, wid = __builtin_amdgcn_readfirstlane(tid >> 6), lane = tid & 63, wr = wid >> 2, wc = wid & 3, fr = lane & 15, fq = lane >> 4;
    int R0, C0, R1, C1; stage_rc(tid * 16, R0, C0); stage_rc(tid * 16 + 8192, R1, C1);
    const int Rb0 = (R0 & ~31) + perm32(R0 & 31), Rb1 = (R1 & ~31) + perm32(R1 & 31);
    const unsigned vB0 = (unsigned)(Rb0 * ldb2 + C0 * 2), vB1 = (unsigned)(Rb1 * ldb2 + C1 * 2);
    const size_t kstep = (size_t)(BK * 2);
    const size_t hstepB = (size_t)HALF * ldb2;
    const unsigned ldsw = (unsigned)wid * 1024u;
    const int aoff = lds_byte(wr * 64 + fr, fq * 8), boff = lds_byte(wc * 32 + fr, fq * 8);
#define PG8_SA(b, h) (((b) * 2 + (h)) * HTB)
#define PG8_SB(b, h) ((4 + (b) * 2 + (h)) * HTB)
#define PG8_STAGE(bufoff, gbase, V0, V1) do { \
        __builtin_amdgcn_global_load_lds((const unsigned*)((const char*)(gbase) + (V0)), (LAS unsigned*)(lds + (bufoff) + ldsw), 16, 0, 0); \
        __builtin_amdgcn_global_load_lds((const unsigned*)((const char*)(gbase) + (V1)), (LAS unsigned*)(lds + (bufoff) + ldsw + 8192), 16, 0, 0); } while (0)
#define PG8_LDA(dst, b, h) do { _Pragma("unroll") for (int m = 0; m < 4; ++m) _Pragma("unroll") for (int k = 0; k < 2; ++k) dst[m][k] = *(const LAS bf16x8*)(lds + PG8_SA(b, h) + aoff + m * 2048 + k * 1024); } while (0)
#define PG8_LDB(dst, b, h) do { _Pragma("unroll") for (int n = 0; n < 2; ++n) _Pragma("unroll") for (int k = 0; k < 2; ++k) dst[n][k] = *(const LAS bf16x8*)(lds + PG8_SB(b, h) + boff + n * 2048 + k * 1024); } while (0)
#define PG8_MMA(ai, bj, At, Bt) do { __builtin_amdgcn_s_setprio(1); _Pragma("unroll") for (int m = 0; m < 4; ++m) _Pragma("unroll") for (int n = 0; n < 2; ++n) _Pragma("unroll") for (int k = 0; k < 2; ++k) \
        acc[ai][bj][m][n] = __builtin_amdgcn_mfma_f32_16x16x32_bf16(Bt[n][k], At[m][k], acc[ai][bj][m][n], 0, 0, 0); __builtin_amdgcn_s_setprio(0); } while (0)
#define PG8_WAIT_V(n) asm volatile("s_waitcnt vmcnt(" #n ")" ::: "memory")
#define PG8_WAIT_L(n) asm volatile("s_waitcnt lgkmcnt(" #n ")" ::: "memory")
#define PG8_BAR __builtin_amdgcn_s_barrier()
#define PG8_SCHED __builtin_amdgcn_sched_barrier(0)
    Unit cur, nxt; int ui = 0;
    if (!S.next(0, cur)) return;
    f32x4 acc[2][2][4][2];
#pragma unroll
    for (int a = 0; a < 2; ++a)
#pragma unroll
        for (int b = 0; b < 2; ++b)
#pragma unroll
            for (int m = 0; m < 4; ++m)
#pragma unroll
                for (int n = 0; n < 2; ++n) acc[a][b][m][n] = (f32x4){0.f, 0.f, 0.f, 0.f};
    bf16x8 At[4][2], B0[2][2], B1[2][2];
    const char* cA = cur.A; const char* cB = cur.B;
    const unsigned vA0 = (unsigned)(R0 * lda2 + C0 * 2), vA1 = (unsigned)(R1 * lda2 + C1 * 2); const size_t hstepA = (size_t)HALF * lda2;
    PG8_STAGE(PG8_SB(0, 0), cB, vB0, vB1); PG8_STAGE(PG8_SB(0, 1), cB + hstepB, vB0, vB1); PG8_STAGE(PG8_SA(0, 0), cA, vA0, vA1); PG8_STAGE(PG8_SA(0, 1), cA + hstepA, vA0, vA1);
    if (wr == 1) PG8_BAR;
    PG8_WAIT_V(2); PG8_BAR;
    PG8_STAGE(PG8_SB(1, 0), cB + kstep, vB0, vB1); PG8_STAGE(PG8_SA(1, 0), cA + kstep, vA0, vA1); PG8_STAGE(PG8_SB(1, 1), cB + hstepB + kstep, vB0, vB1);
    PG8_WAIT_V(6); PG8_BAR;
    for (;;) {
        const bool has_next = S.next(ui + 1, nxt);
        const char* nA = has_next ? nxt.A : cA; const char* nB = has_next ? nxt.B : cB;
        for (int t = 0; t < nt; t += 2) {
            const bool last = (t == nt - 2);
            const char* a1 = cA + (size_t)(t + 1) * kstep;
            const char* a2 = last ? nA : cA + (size_t)(t + 2) * kstep; const char* b2 = last ? nB : cB + (size_t)(t + 2) * kstep;
            const char* a3 = a2 + kstep; const char* b3 = b2 + kstep;
            PG8_LDB(B0, 0, 0); PG8_LDB(B1, 0, 1); PG8_SCHED; PG8_LDA(At, 0, 0); PG8_STAGE(PG8_SA(1, 1), a1 + hstepA, vA0, vA1);
            PG8_WAIT_V(8); PG8_WAIT_L(0); PG8_BAR; PG8_MMA(0, 0, At, B0); PG8_MMA(0, 1, At, B1); PG8_BAR; PG8_SCHED;
            PG8_LDA(At, 0, 1); PG8_STAGE(PG8_SB(0, 0), b2, vB0, vB1); PG8_STAGE(PG8_SB(0, 1), b2 + hstepB, vB0, vB1); PG8_STAGE(PG8_SA(0, 0), a2, vA0, vA1);
            PG8_WAIT_V(8); PG8_WAIT_L(0); PG8_BAR; PG8_MMA(1, 0, At, B0); PG8_MMA(1, 1, At, B1); PG8_BAR; PG8_SCHED;
            PG8_LDB(B0, 1, 0); PG8_LDB(B1, 1, 1); PG8_SCHED; PG8_LDA(At, 1, 0); PG8_STAGE(PG8_SA(0, 1), a2 + hstepA, vA0, vA1);
            PG8_WAIT_V(8); PG8_WAIT_L(0); PG8_BAR; PG8_MMA(0, 0, At, B0); PG8_MMA(0, 1, At, B1); PG8_BAR; PG8_SCHED;
            PG8_LDA(At, 1, 1); PG8_STAGE(PG8_SB(1, 0), b3, vB0, vB1); PG8_STAGE(PG8_SB(1, 1), b3 + hstepB, vB0, vB1); PG8_STAGE(PG8_SA(1, 0), a3, vA0, vA1);
            PG8_WAIT_V(8); PG8_WAIT_L(0); PG8_BAR; PG8_MMA(1, 0, At, B0); PG8_MMA(1, 1, At, B1); PG8_BAR; PG8_SCHED;
        }
        if (wr == 0) PG8_BAR;
        asm volatile("s_nop 7\n\ts_nop 7\n\ts_nop 3" ::: "memory");
        E(acc, cur, wr, wc, fr, fq);
        if (!has_next) break;
        if (E.reset(cur)) {
#pragma unroll
        for (int a = 0; a < 2; ++a)
#pragma unroll
            for (int b = 0; b < 2; ++b)
#pragma unroll
                for (int m = 0; m < 4; ++m)
#pragma unroll
                    for (int n = 0; n < 2; ++n) acc[a][b][m][n] = (f32x4){0.f, 0.f, 0.f, 0.f};
        }
        cur = nxt; cA = nA; cB = nB; ++ui;
        if (wr == 1) PG8_BAR;
    }
    PG8_WAIT_V(0);
    PG8_BAR;
#undef PG8_SA
#undef PG8_SB
#undef PG8_STAGE
#undef PG8_LDA
#undef PG8_LDB
#undef PG8_MMA
#undef PG8_WAIT_V
#undef PG8_WAIT_L
#undef PG8_BAR
#undef PG8_SCHED
}

typedef f32x4 AccT[2][2][4][2];
struct EpiIn {
    bf16_t* Z; const LAS float* ropeT;
    DI bool reset(const Unit&) const { return true; }
    DI void operator()(AccT& acc, const Unit& u, int wr, int wc, int fr, int fq) const {
        asm volatile("" : "+v"(fr), "+v"(fq));
        const int pn = u.pn, pmb = u.pm % 17; const bool lat = pmb != 16;
        const bool gate = pn >= 11;
        const bool ropet = lat && (pn <= 3 || (pn >= 8 && pn <= 10));
#pragma unroll
        for (int ai = 0; ai < 2; ++ai)
#pragma unroll
            for (int m = 0; m < 4; ++m) {
                const int rt = ai * 128 + wr * 64 + m * 16 + fr; const size_t row = (size_t)u.pm * 256 + rt; const int npos = pmb * 256 + rt;
#pragma unroll
                for (int bj = 0; bj < 2; ++bj) {
                    const int col = pn * 256 + bj * 128 + wc * 32 + 8 * fq; f32x4 v0 = acc[ai][bj][m][0], v1 = acc[ai][bj][m][1];
                    if (gate) {
#pragma unroll
                        for (int e = 0; e < 4; ++e) { v0[e] = sigmoidf_(v0[e]); v1[e] = sigmoidf_(v1[e]); }
                    } else if (ropet && !(pn == 10 && bj == 1)) {
                        const int i_ = (col & 63) >> 1; const int pos_ = (i_ < 16) ? (npos >> 6) : (npos & 63);
                        const LAS float* tp = ropeT + (pos_ * 16 + (i_ & 15)) * 2;
                        const f32x4 T0 = *(const LAS f32x4*)tp, T1 = *(const LAS f32x4*)(tp + 4), T2 = *(const LAS f32x4*)(tp + 8), T3 = *(const LAS f32x4*)(tp + 12);
                        f32x4 a, b;
                        a[0] = v0[0] * T0[0] - v0[1] * T0[1]; a[1] = v0[0] * T0[1] + v0[1] * T0[0]; a[2] = v0[2] * T0[2] - v0[3] * T0[3]; a[3] = v0[2] * T0[3] + v0[3] * T0[2];
                        b[0] = v1[0] * T1[0] - v1[1] * T1[1]; b[1] = v1[0] * T1[1] + v1[1] * T1[0]; b[2] = v1[2] * T1[2] - v1[3] * T1[3]; b[3] = v1[2] * T1[3] + v1[3] * T1[2];
                        v0 = a; v1 = b; (void)T2; (void)T3;
                    } else { v0 = v0 + 0.f; v1 = v1 + 0.f; }
                    u32x4 w; w.x = pk2c(v0[0], v0[1]); w.y = pk2c(v0[2], v0[3]); w.z = pk2c(v1[0], v1[1]); w.w = pk2c(v1[2], v1[3]);
                    *(u32x4*)(Z + row * ZLD + col) = w;
                }
            }
    }
};
struct EpiMerge {
    bf16_t* Z;
    DI bool reset(const Unit& u) const { return u.br == 2; }
    DI void operator()(AccT& acc, const Unit& u, int wr, int wc, int fr, int fq) const {
        asm volatile("" : "+v"(fr), "+v"(fq));
        const int br = u.br;
#pragma unroll
        for (int ai = 0; ai < 2; ++ai) {
            u32x4 ga[4][2], gb[4][2];
#pragma unroll
            for (int m = 0; m < 4; ++m) { const size_t row = (size_t)u.pm * 256 + ai * 128 + wr * 64 + m * 16 + fr;
#pragma unroll
                for (int bj = 0; bj < 2; ++bj) { const bf16_t* gp = Z + row * ZLD + ZC_G + br * 1024 + u.pn * 256 + bj * 128 + wc * 32 + 8 * fq;
                    ga[m][bj] = *(const u32x4*)gp; gb[m][bj] = (br < 2) ? *(const u32x4*)(gp + 1024) : (u32x4){0x3f803f80u, 0x3f803f80u, 0x3f803f80u, 0x3f803f80u}; } }
            __builtin_amdgcn_sched_barrier(0);
#pragma unroll
            for (int m = 0; m < 4; ++m) { const size_t row = (size_t)u.pm * 256 + ai * 128 + wr * 64 + m * 16 + fr;
#pragma unroll
                for (int bj = 0; bj < 2; ++bj) { const int col = u.pn * 256 + bj * 128 + wc * 32 + 8 * fq;
                    const u32x4 gw = ga[m][bj], hw = gb[m][bj];
                    f32x4 g0, g1;
                    g0[0] = fmaxf(bflo(gw.x), 1e-18f); g0[1] = fmaxf(bfhi(gw.x), 1e-18f); g0[2] = fmaxf(bflo(gw.y), 1e-18f); g0[3] = fmaxf(bfhi(gw.y), 1e-18f);
                    g1[0] = fmaxf(bflo(gw.z), 1e-18f); g1[1] = fmaxf(bfhi(gw.z), 1e-18f); g1[2] = fmaxf(bflo(gw.w), 1e-18f); g1[3] = fmaxf(bfhi(gw.w), 1e-18f);
                    if (br < 2) {
                        g0[0] *= __builtin_amdgcn_rcpf(fmaxf(bflo(hw.x), 1e-18f)); g0[1] *= __builtin_amdgcn_rcpf(fmaxf(bfhi(hw.x), 1e-18f));
                        g0[2] *= __builtin_amdgcn_rcpf(fmaxf(bflo(hw.y), 1e-18f)); g0[3] *= __builtin_amdgcn_rcpf(fmaxf(bfhi(hw.y), 1e-18f));
                        g1[0] *= __builtin_amdgcn_rcpf(fmaxf(bflo(hw.z), 1e-18f)); g1[1] *= __builtin_amdgcn_rcpf(fmaxf(bfhi(hw.z), 1e-18f));
                        g1[2] *= __builtin_amdgcn_rcpf(fmaxf(bflo(hw.w), 1e-18f)); g1[3] *= __builtin_amdgcn_rcpf(fmaxf(bfhi(hw.w), 1e-18f));
                        acc[ai][bj][m][0] = acc[ai][bj][m][0] * g0; acc[ai][bj][m][1] = acc[ai][bj][m][1] * g1;
                    } else {
                        const f32x4 v0 = acc[ai][bj][m][0] * g0, v1 = acc[ai][bj][m][1] * g1;
                        u32x4 w; w.x = pk2c(v0[0], v0[1]); w.y = pk2c(v0[2], v0[3]); w.z = pk2c(v1[0], v1[1]); w.w = pk2c(v1[2], v1[3]);
                        *(u32x4*)(Z + row * ZLD + ZC_M + col) = w;
                    }
                } }
            __builtin_amdgcn_sched_barrier(0);
        }
    }
};
struct EpiOut {
    bf16_t* O; float* SS;
    DI bool reset(const Unit&) const { return true; }
    DI void operator()(AccT& acc, const Unit& u, int wr, int wc, int fr, int fq) const {
        asm volatile("" : "+v"(fr), "+v"(fq));
#pragma unroll
        for (int ai = 0; ai < 2; ++ai)
#pragma unroll
            for (int m = 0; m < 4; ++m) {
                const int rt = ai * 128 + wr * 64 + m * 16 + fr; const size_t row = (size_t)u.pm * 256 + rt; float s = 0.f;
#pragma unroll
                for (int bj = 0; bj < 2; ++bj) {
                    const int col = u.pn * 256 + bj * 128 + wc * 32 + 8 * fq; const f32x4 v0 = acc[ai][bj][m][0], v1 = acc[ai][bj][m][1];
                    s += (v0[0] * v0[0] + v0[1] * v0[1]) + (v0[2] * v0[2] + v0[3] * v0[3]); s += (v1[0] * v1[0] + v1[1] * v1[1]) + (v1[2] * v1[2] + v1[3] * v1[3]);
                    u32x4 w; w.x = pk2c(v0[0], v0[1]); w.y = pk2c(v0[2], v0[3]); w.z = pk2c(v1[0], v1[1]); w.w = pk2c(v1[2], v1[3]);
                    *(u32x4*)(O + row * DM + col) = w;
                }
                s += __shfl_xor(s, 16); s += __shfl_xor(s, 32);
                if (fq == 0) SS[row * 16 + u.pn * 4 + wc] = s;
            }
    }
};
struct EpiFfn {
    bf16_t* Hd;
    DI bool reset(const Unit&) const { return true; }
    DI void operator()(AccT& acc, const Unit& u, int wr, int wc, int fr, int fq) const {
        asm volatile("" : "+v"(fr), "+v"(fq));
#pragma unroll
        for (int ai = 0; ai < 2; ++ai)
#pragma unroll
            for (int m = 0; m < 4; ++m) {
                const int rt = ai * 128 + wr * 64 + m * 16 + fr; const size_t row = (size_t)u.pm * 256 + rt;
                const int col = u.pn * 128 + wc * 32 + 8 * fq; f32x4 v0, v1;
#pragma unroll
                for (int e = 0; e < 4; ++e) { const float g0 = acc[ai][0][m][0][e], g1 = acc[ai][0][m][1][e];
                    v0[e] = g0 * sigmoidf_(g0) * acc[ai][1][m][0][e]; v1[e] = g1 * sigmoidf_(g1) * acc[ai][1][m][1][e]; }
                u32x4 w; w.x = pk2c(v0[0], v0[1]); w.y = pk2c(v0[2], v0[3]); w.z = pk2c(v1[0], v1[1]); w.w = pk2c(v1[2], v1[3]);
                *(u32x4*)(Hd + row * DFF + col) = w;
            }
    }
};
}

namespace att {
constexpr int KROWB = 144, KBUF = 64 * KROWB, VBUF = 16384;
constexpr int L_K = 0, L_V = 2 * KBUF, L_WS = L_V + 2 * VBUF, L_END = L_WS + 8 * 256;
constexpr float SCALE = 0.125f, CL2 = SCALE * 1.4426950408889634f, THRS = 8.f / SCALE;
DI int crow(int r, int hi) { return (r & 3) + 8 * (r >> 2) + 4 * hi; }
DI unsigned cvtpk(float lo, float hi) { unsigned r; asm volatile("v_cvt_pk_bf16_f32 %0, %1, %2" : "=v"(r) : "v"(lo), "v"(hi)); return r; }
template <int DV> DI int v_st(int k, int c) { constexpr int NCB = DV / 32; const int kk = (k & ~0xC) | ((k & 4) << 1) | ((k & 8) >> 1); return ((kk >> 3) * NCB + (c >> 5)) * 512 + ((kk & 7) * 32 + (c & 31)) * 2; }
DI int v_rd_base(int lane) { return ((lane & 3) << 3) | (((lane >> 2) & 3) << 6) | (((lane >> 4) & 1) << 5) | (((lane >> 5) & 1) << 8); }
template <int DV> constexpr int v_rd_off(int d0, int ks, int half) { return d0 * 512 + (ks * 2 + half) * (DV / 32) * 512; }
template <int OFF> DI s16x4 tr_read(int vb) { s16x4 r; asm volatile("ds_read_b64_tr_b16 %0, %1 offset:%2" : "=&v"(r) : "v"(vb), "i"(OFF) : "memory"); return r; }
template <int DV, int D0> DI void pv_one(f32x16& od, int vb, bf16x8 pa0, bf16x8 pa1, bf16x8 pa2, bf16x8 pa3) {
    const s16x4 l0 = tr_read<v_rd_off<DV>(D0, 0, 0)>(vb), h0 = tr_read<v_rd_off<DV>(D0, 0, 1)>(vb), l1 = tr_read<v_rd_off<DV>(D0, 1, 0)>(vb), h1 = tr_read<v_rd_off<DV>(D0, 1, 1)>(vb);
    const s16x4 l2 = tr_read<v_rd_off<DV>(D0, 2, 0)>(vb), h2 = tr_read<v_rd_off<DV>(D0, 2, 1)>(vb), l3 = tr_read<v_rd_off<DV>(D0, 3, 0)>(vb), h3 = tr_read<v_rd_off<DV>(D0, 3, 1)>(vb);
    asm volatile("s_waitcnt lgkmcnt(0)" ::: "memory"); __builtin_amdgcn_sched_barrier(0);
#define ATT_PK(L, H) (bf16x8){L[0], L[1], L[2], L[3], H[0], H[1], H[2], H[3]}
    od = __builtin_amdgcn_mfma_f32_32x32x16_bf16(pa0, ATT_PK(l0, h0), od, 0, 0, 0);
    od = __builtin_amdgcn_mfma_f32_32x32x16_bf16(pa1, ATT_PK(l1, h1), od, 0, 0, 0);
    od = __builtin_amdgcn_mfma_f32_32x32x16_bf16(pa2, ATT_PK(l2, h2), od, 0, 0, 0);
    od = __builtin_amdgcn_mfma_f32_32x32x16_bf16(pa3, ATT_PK(l3, h3), od, 0, 0, 0);
#undef ATT_PK
}
struct TileList { int a0, na, b0, nb; };

template <int DV, bool MASK>
DI void attn_pass(LAS unsigned char* lds, const bf16_t* __restrict__ Zb, size_t qoff, int kcol, int vcol, const TileList tl, int jq, int qpos0, float m_init, float l_init, f32x16 (&o)[DV / 32], float& l_out) {
    constexpr int NCB = DV / 32;
    int tid_ = threadIdx.x; asm volatile("" : "+v"(tid_));
    const int tid = tid_, wid = tid >> 6, lane = tid & 63, r32 = lane & 31, hi = lane >> 5;
    LAS unsigned char* Kl = lds + L_K; LAS unsigned char* Vl = lds + L_V; LAS float* wsf = (LAS float*)(lds + L_WS) + wid * 64;
    bf16x8 qr[4];
#pragma unroll
    for (int d0 = 0; d0 < 4; ++d0) qr[d0] = *(const bf16x8*)(Zb + qoff + (size_t)r32 * ZLD + d0 * 16 + hi * 8);
    const int krow_t = tid >> 3, kch = tid & 7;
    const size_t kg = (size_t)krow_t * ZLD + kcol + kch * 8; const int kl = krow_t * KROWB + kch * 16;
    const int sr = (DV == 128) ? (tid >> 4) : (tid >> 3), sc = (DV == 128) ? (tid & 15) * 8 : (tid & 7) * 8;
    const size_t vg0 = (size_t)sr * ZLD + vcol + sc, vg1 = (size_t)(32 + sr) * ZLD + vcol + sc;
    const int vl0 = v_st<DV>(sr, sc), vl1 = v_st<DV>(32 + sr, sc);
    const int vb0 = (int)(uintptr_t)Vl + v_rd_base(lane);
    const int NT = tl.na + tl.nb;
#define ATT_TILE(j) ((j) < tl.na ? tl.a0 + (j) : tl.b0 + ((j) - tl.na))
    bf16x8 ks, vs0, vs1 = {};
#define ATT_GLOAD(j) do { const bf16_t* tb_ = Zb + (size_t)ATT_TILE(j) * 64 * ZLD; ks = *(const bf16x8*)(tb_ + kg); vs0 = *(const bf16x8*)(tb_ + vg0); if (DV == 128) vs1 = *(const bf16x8*)(tb_ + vg1); } while (0)
#define ATT_SWRITE(b) do { *(LAS bf16x8*)(Kl + (b) * KBUF + kl) = ks; *(LAS bf16x8*)(Vl + (b) * VBUF + vl0) = vs0; if (DV == 128) *(LAS bf16x8*)(Vl + (b) * VBUF + vl1) = vs1; } while (0)
    float m_reg = m_init, l_reg = l_init;
#pragma unroll
    for (int d = 0; d < NCB; ++d)
#pragma unroll
        for (int r = 0; r < 16; ++r) o[d][r] = 0.f;
    ATT_GLOAD(0); ATT_SWRITE(0); if (NT > 1) ATT_GLOAD(1);
    __syncthreads();
    for (int j = 0; j < NT; ++j) {
        const int cur = j & 1;
        if (j + 1 < NT) ATT_SWRITE(cur ^ 1);
        if (j + 2 < NT) ATT_GLOAD(j + 2);
        const LAS unsigned char* Kb = Kl + cur * KBUF;
        f32x16 p0, p1;
#pragma unroll
        for (int r = 0; r < 16; ++r) { p0[r] = 0.f; p1[r] = 0.f; }
#pragma unroll
        for (int d0 = 0; d0 < 4; ++d0) { const int cb = d0 * 32 + hi * 16;
            const bf16x8 b0 = *(const LAS bf16x8*)(Kb + r32 * KROWB + cb), b1 = *(const LAS bf16x8*)(Kb + (32 + r32) * KROWB + cb);
            p0 = __builtin_amdgcn_mfma_f32_32x32x16_bf16(b0, qr[d0], p0, 0, 0, 0);
            p1 = __builtin_amdgcn_mfma_f32_32x32x16_bf16(b1, qr[d0], p1, 0, 0, 0); }
        if (MASK) { const int t = ATT_TILE(j);
            if (j >= tl.na && (t == jq - 2 || t == jq + 2)) { const int dq = t * 64 - qpos0 - r32;
#pragma unroll
                for (int r = 0; r < 16; ++r) { const int d0_ = dq + crow(r, hi), d1_ = d0_ + 32;
                    if (d0_ > 128 || d0_ < -128) p0[r] = -1e30f; if (d1_ > 128 || d1_ < -128) p1[r] = -1e30f; } } }
        float pmax = p0[0];
#pragma unroll
        for (int r = 1; r < 16; ++r) pmax = fmaxf(pmax, p0[r]);
#pragma unroll
        for (int r = 0; r < 16; ++r) pmax = fmaxf(pmax, p1[r]);
        { auto rr = __builtin_amdgcn_permlane32_swap(__float_as_uint(pmax), __float_as_uint(pmax), false, false); pmax = fmaxf(__uint_as_float(rr[0]), __uint_as_float(rr[1])); }
        float mn, alpha;
        if (__all(pmax - m_reg <= THRS)) { mn = m_reg; alpha = 1.f; }
        else { mn = fmaxf(m_reg, pmax); alpha = __builtin_amdgcn_exp2f((m_reg - mn) * CL2); m_reg = mn; }
        const float mnC = -mn * CL2;
#pragma unroll
        for (int r = 0; r < 16; ++r) { p0[r] = __builtin_amdgcn_exp2f(fmaf(p0[r], CL2, mnC)); p1[r] = __builtin_amdgcn_exp2f(fmaf(p1[r], CL2, mnC)); }
        float ps = 0.f;
#pragma unroll
        for (int r = 0; r < 16; ++r) ps += p0[r] + p1[r];
        { auto rr = __builtin_amdgcn_permlane32_swap(__float_as_uint(ps), __float_as_uint(ps), false, false); ps = __uint_as_float(rr[0]) + __uint_as_float(rr[1]); }
        l_reg = l_reg * alpha + ps;
        if (__any(alpha < 1.f)) {
            if (hi == 0) wsf[r32] = alpha;
            asm volatile("s_waitcnt lgkmcnt(0)" ::: "memory");
#pragma unroll
            for (int r = 0; r < 16; ++r) { const float a = wsf[crow(r, hi)];
#pragma unroll
                for (int d = 0; d < NCB; ++d) o[d][r] *= a; }
        }
        bf16x8 pa0, pa1, pa2, pa3;
#define ATT_PK4(P, BASE, OUT) do { unsigned a0 = cvtpk(P[BASE + 0], P[BASE + 1]), a1 = cvtpk(P[BASE + 2], P[BASE + 3]); \
        unsigned b0_ = cvtpk(P[BASE + 4], P[BASE + 5]), b1_ = cvtpk(P[BASE + 6], P[BASE + 7]); \
        auto r0 = __builtin_amdgcn_permlane32_swap(a0, b0_, false, false); auto r1 = __builtin_amdgcn_permlane32_swap(a1, b1_, false, false); \
        u32x4 w = {r0[0], r1[0], r0[1], r1[1]}; OUT = __builtin_bit_cast(bf16x8, w); } while (0)
        ATT_PK4(p0, 0, pa0); ATT_PK4(p0, 8, pa1); ATT_PK4(p1, 0, pa2); ATT_PK4(p1, 8, pa3);
#undef ATT_PK4
        const int vb = vb0 + cur * VBUF;
        pv_one<DV, 0>(o[0], vb, pa0, pa1, pa2, pa3); pv_one<DV, 1>(o[1], vb, pa0, pa1, pa2, pa3);
        if constexpr (DV == 128) { pv_one<DV, 2>(o[2], vb, pa0, pa1, pa2, pa3); pv_one<DV, 3>(o[3], vb, pa0, pa1, pa2, pa3); }
        __syncthreads();
    }
    l_out = l_reg;
#undef ATT_TILE
#undef ATT_GLOAD
#undef ATT_SWRITE
}
DI void partialSM(f32x16& p0, f32x16& p1, float& m_reg, float& mn, float& alpha) {
    float pmax = p0[0];
#pragma unroll
    for (int r = 1; r < 16; ++r) pmax = fmaxf(pmax, p0[r]);
#pragma unroll
    for (int r = 0; r < 16; ++r) pmax = fmaxf(pmax, p1[r]);
    { auto rr = __builtin_amdgcn_permlane32_swap(__float_as_uint(pmax), __float_as_uint(pmax), false, false); pmax = fmaxf(__uint_as_float(rr[0]), __uint_as_float(rr[1])); }
    if (__builtin_expect(__all(pmax - m_reg <= THRS), 1)) { mn = m_reg; alpha = 1.f; }
    else { mn = fmaxf(m_reg, pmax); alpha = __builtin_amdgcn_exp2f((m_reg - mn) * CL2); m_reg = mn; }
    const float mnC = -mn * CL2;
#pragma unroll
    for (int r = 0; r < 16; ++r) p0[r] = fmaf(p0[r], CL2, mnC);
#pragma unroll
    for (int r = 0; r < 16; ++r) p1[r] = fmaf(p1[r], CL2, mnC);
#pragma unroll
    for (int r = 0; r < 16; ++r) p0[r] = __builtin_amdgcn_exp2f(p0[r]);
}
DI void finishSM(f32x16& p0, f32x16& p1, float alpha, float& l_reg, bf16x8& pa0, bf16x8& pa1, bf16x8& pa2, bf16x8& pa3) {
#pragma unroll
    for (int r = 0; r < 16; ++r) p1[r] = __builtin_amdgcn_exp2f(p1[r]);
    float ps = 0.f;
#pragma unroll
    for (int r = 0; r < 16; ++r) ps += p0[r];
#pragma unroll
    for (int r = 0; r < 16; ++r) ps += p1[r];
    { auto rr = __builtin_amdgcn_permlane32_swap(__float_as_uint(ps), __float_as_uint(ps), false, false); ps = __uint_as_float(rr[0]) + __uint_as_float(rr[1]); }
    l_reg = l_reg * alpha + ps;
#define ATT_PK4(P, BASE, OUT) do { unsigned a0 = cvtpk(P[BASE + 0], P[BASE + 1]), a1 = cvtpk(P[BASE + 2], P[BASE + 3]); \
    unsigned b0_ = cvtpk(P[BASE + 4], P[BASE + 5]), b1_ = cvtpk(P[BASE + 6], P[BASE + 7]); \
    auto r0 = __builtin_amdgcn_permlane32_swap(a0, b0_, false, false); auto r1 = __builtin_amdgcn_permlane32_swap(a1, b1_, false, false); \
    u32x4 w = {r0[0], r1[0], r0[1], r1[1]}; OUT = __builtin_bit_cast(bf16x8, w); } while (0)
    ATT_PK4(p0, 0, pa0); ATT_PK4(p0, 8, pa1); ATT_PK4(p1, 0, pa2); ATT_PK4(p1, 8, pa3);
#undef ATT_PK4
}
DI void qkt64(f32x16& p0, f32x16& p1, const LAS unsigned char* Kb, const bf16x8 (&qr)[4], int r32, int hi) {
#pragma unroll
    for (int r = 0; r < 16; ++r) { p0[r] = 0.f; p1[r] = 0.f; }
#pragma unroll
    for (int d0 = 0; d0 < 4; ++d0) { const int cb = d0 * 32 + hi * 16;
        const bf16x8 b0 = *(const LAS bf16x8*)(Kb + r32 * KROWB + cb), b1 = *(const LAS bf16x8*)(Kb + (32 + r32) * KROWB + cb);
        p0 = __builtin_amdgcn_mfma_f32_32x32x16_bf16(b0, qr[d0], p0, 0, 0, 0);
        p1 = __builtin_amdgcn_mfma_f32_32x32x16_bf16(b1, qr[d0], p1, 0, 0, 0); }
}
DI void pv128(f32x16 (&o)[4], int vb, bf16x8 pa0, bf16x8 pa1, bf16x8 pa2, bf16x8 pa3) {
    pv_one<128, 0>(o[0], vb, pa0, pa1, pa2, pa3); pv_one<128, 1>(o[1], vb, pa0, pa1, pa2, pa3); pv_one<128, 2>(o[2], vb, pa0, pa1, pa2, pa3); pv_one<128, 3>(o[3], vb, pa0, pa1, pa2, pa3);
}
DI void attn_pass_pipe(LAS unsigned char* lds, const bf16_t* __restrict__ Zb, size_t qoff, int kcol, int vcol, int t0, int NT, f32x16 (&o)[4], float& l_out) {
    int tid_ = threadIdx.x; asm volatile("" : "+v"(tid_));
    const int tid = tid_, wid = tid >> 6, lane = tid & 63, r32 = lane & 31, hi = lane >> 5;
    LAS unsigned char* Kl = lds + L_K; LAS unsigned char* Vl = lds + L_V; LAS float* wsf = (LAS float*)(lds + L_WS) + wid * 64;
    bf16x8 qr[4];
#pragma unroll
    for (int d0 = 0; d0 < 4; ++d0) qr[d0] = *(const bf16x8*)(Zb + qoff + (size_t)r32 * ZLD + d0 * 16 + hi * 8);
    const int krow_t = tid >> 3, kch = tid & 7;
    const bf16_t* kgp = Zb + (size_t)t0 * 64 * ZLD + (size_t)krow_t * ZLD + kcol + kch * 8; const int kl = krow_t * KROWB + kch * 16;
    const int sr = tid >> 4, sc = (tid & 15) * 8;
    const bf16_t* vgp0 = Zb + (size_t)t0 * 64 * ZLD + (size_t)sr * ZLD + vcol + sc; const bf16_t* vgp1 = vgp0 + (size_t)32 * ZLD;
    const int vl0 = v_st<128>(sr, sc), vl1 = v_st<128>(32 + sr, sc);
    const int vb0 = (int)(uintptr_t)Vl + v_rd_base(lane);
    constexpr size_t TSTEP = (size_t)64 * ZLD;
    bf16x8 ksE, v0E, v1E, ksO, v0O, v1O;
#define PP_LOADE(j) do { ksE = *(const bf16x8*)(kgp + (size_t)(j) * TSTEP); v0E = *(const bf16x8*)(vgp0 + (size_t)(j) * TSTEP); v1E = *(const bf16x8*)(vgp1 + (size_t)(j) * TSTEP); } while (0)
#define PP_LOADO(j) do { ksO = *(const bf16x8*)(kgp + (size_t)(j) * TSTEP); v0O = *(const bf16x8*)(vgp0 + (size_t)(j) * TSTEP); v1O = *(const bf16x8*)(vgp1 + (size_t)(j) * TSTEP); } while (0)
#define PP_WRITEE() do { *(LAS bf16x8*)(Kl + kl) = ksE; *(LAS bf16x8*)(Vl + vl0) = v0E; *(LAS bf16x8*)(Vl + vl1) = v1E; } while (0)
#define PP_WRITEO() do { *(LAS bf16x8*)(Kl + KBUF + kl) = ksO; *(LAS bf16x8*)(Vl + VBUF + vl0) = v0O; *(LAS bf16x8*)(Vl + VBUF + vl1) = v1O; } while (0)
#define PP_RESC(a) do { if (__any((a) < 1.f)) { if (hi == 0) wsf[r32] = (a); asm volatile("s_waitcnt lgkmcnt(0)" ::: "memory"); \
    _Pragma("unroll") for (int r = 0; r < 16; ++r) { const float a_ = wsf[crow(r, hi)]; _Pragma("unroll") for (int d = 0; d < 4; ++d) o[d][r] *= a_; } } } while (0)
#define PP_SB() __builtin_amdgcn_sched_barrier(0)
    float m_reg = -1e30f, l_reg = 0.f;
#pragma unroll
    for (int d = 0; d < 4; ++d)
#pragma unroll
        for (int r = 0; r < 16; ++r) o[d][r] = 0.f;
    f32x16 pA0, pA1, pB0, pB1; float mnA, mnB, alA, alB; bf16x8 pa0, pa1, pa2, pa3;
    if (__builtin_amdgcn_readfirstlane(wid) >= 4) __builtin_amdgcn_s_setprio(1);
    PP_LOADE(0); PP_WRITEE(); __syncthreads();
    qkt64(pA0, pA1, Kl, qr, r32, hi); partialSM(pA0, pA1, m_reg, mnA, alA);
    PP_LOADO(1); PP_LOADE(2);
    PP_WRITEO(); __syncthreads();
    for (int j = 1; j + 1 < NT; j += 2) {
        PP_SB(); qkt64(pB0, pB1, Kl + KBUF, qr, r32, hi);
        finishSM(pA0, pA1, alA, l_reg, pa0, pa1, pa2, pa3); PP_SB();
        PP_LOADO(j + 2); PP_SB();
        pv128(o, vb0, pa0, pa1, pa2, pa3); partialSM(pB0, pB1, m_reg, mnB, alB);
        __syncthreads(); PP_WRITEE();
        PP_RESC(alB); __syncthreads();
        PP_SB(); qkt64(pA0, pA1, Kl, qr, r32, hi);
        finishSM(pB0, pB1, alB, l_reg, pa0, pa1, pa2, pa3); PP_SB();
        if (j + 3 < NT) PP_LOADE(j + 3); PP_SB();
        pv128(o, vb0 + VBUF, pa0, pa1, pa2, pa3); partialSM(pA0, pA1, m_reg, mnA, alA);
        __syncthreads(); PP_WRITEO();
        PP_RESC(alA); __syncthreads();
    }
    PP_SB(); qkt64(pB0, pB1, Kl + KBUF, qr, r32, hi);
    finishSM(pA0, pA1, alA, l_reg, pa0, pa1, pa2, pa3); PP_SB();
    pv128(o, vb0, pa0, pa1, pa2, pa3); partialSM(pB0, pB1, m_reg, mnB, alB);
    __syncthreads(); PP_RESC(alB);
    finishSM(pB0, pB1, alB, l_reg, pa0, pa1, pa2, pa3); PP_SB();
    pv128(o, vb0 + VBUF, pa0, pa1, pa2, pa3);
    __builtin_amdgcn_s_setprio(0);
    __syncthreads();
    l_out = l_reg;
#undef PP_LOADE
#undef PP_LOADO
#undef PP_WRITEE
#undef PP_WRITEO
#undef PP_RESC
#undef PP_SB
}
DI void row_rcp(LAS unsigned char* lds, float l, float (&rli)[16]) {
    int tid_ = threadIdx.x; asm volatile("" : "+v"(tid_));
    const int tid = tid_, wid = tid >> 6, lane = tid & 63, r32 = lane & 31, hi = lane >> 5;
    LAS float* wsf = (LAS float*)(lds + L_WS) + wid * 64;
    if (hi == 0) wsf[32 + r32] = l;
    asm volatile("s_waitcnt lgkmcnt(0)" ::: "memory");
#pragma unroll
    for (int r = 0; r < 16; ++r) rli[r] = __builtin_amdgcn_rcpf(wsf[32 + crow(r, hi)]);
}
}

DI void transpose_item(const float* __restrict__ W, int N, bf16_t* WT, int ldt, int koff, int item, int nblk, bool ffnmap, LAS float* scr, int lane) {
    const int kb = item / nblk, nb = item % nblk, k0 = 64 * kb, n0 = 32 * nb;
#pragma unroll 8
    for (int i = 0; i < 32; ++i) { const int kk = 2 * i + (lane >> 5); scr[kk * 33 + (lane & 31)] = W[(size_t)(k0 + kk) * N + n0 + (lane & 31)]; }
    asm volatile("s_waitcnt lgkmcnt(0)" ::: "memory");
    const int c = lane & 7;
#pragma unroll
    for (int j = 0; j < 4; ++j) { const int n = (lane >> 3) + 8 * j; const LAS float* s = scr + (8 * c) * 33 + n;
        u32x4 o; o.x = pk2(s[0 * 33], s[1 * 33]); o.y = pk2(s[2 * 33], s[3 * 33]); o.z = pk2(s[4 * 33], s[5 * 33]); o.w = pk2(s[6 * 33], s[7 * 33]);
        int drow = n0 + n;
        if (ffnmap) { drow = (drow < DFF) ? ((drow >> 7) * 256 + (drow & 127)) : ((((drow - DFF) >> 7) * 256) + 128 + ((drow - DFF) & 127)); }
        *(u32x4*)(WT + (size_t)drow * ldt + koff + k0 + 8 * c) = o; }
    asm volatile("s_waitcnt lgkmcnt(0)" ::: "memory");
}

DI void conv_weights(const Cx& a, int l, LAS unsigned char* lds, int tid, int gw, int NGW, int p_lo, int p_hi) {
    const int lane = tid & 63, wave = tid >> 6;
    LAS float* scr = (LAS float*)(lds + wave * 8704);
    unsigned char* wb = a.ws + wb_off(l);
    const float* w_in = a.inp(7) + (size_t)l * DM * INW; const float* w_br = a.inp(13) + (size_t)l * 3 * 512 * DM; const float* w_o = a.inp(14) + (size_t)l * DM * DM;
    const float* w_fi = a.inp(15) + (size_t)l * DM * 2 * DFF; const float* w_fo = a.inp(16) + (size_t)l * DFF * DM;
    constexpr int I_IN = (DM / 64) * (INW / 32), I_B = (512 / 64) * (DM / 32), I_O = (DM / 64) * (DM / 32), I_FI = (DM / 64) * (2 * DFF / 32), I_FO = (DFF / 64) * (DM / 32);
    constexpr int NITEMS = I_IN + 2 * I_B + I_O + I_FI + I_FO;
    const int np = p_hi - p_lo;
    for (int jt = gw; jt < (NITEMS / 8) * np; jt += NGW) {
        const int it = (jt / np) * 8 + p_lo + jt % np; int r = it;
        if (r < I_IN) { transpose_item(w_in, INW, (bf16_t*)(wb + WB_IN), DM, 0, r, INW / 32, false, scr, lane); continue; } r -= I_IN;
        if (r < I_B) { transpose_item(w_br, DM, (bf16_t*)(wb + WB_BR), 1536, 0, r, DM / 32, false, scr, lane); continue; } r -= I_B;
        if (r < I_B) { transpose_item(w_br + (size_t)2 * 512 * DM, DM, (bf16_t*)(wb + WB_BR), 1536, 1024, r, DM / 32, false, scr, lane); continue; } r -= I_B;
        if (r < I_O) { transpose_item(w_o, DM, (bf16_t*)(wb + WB_O), DM, 0, r, DM / 32, false, scr, lane); continue; } r -= I_O;
        if (r < I_FI) { transpose_item(w_fi, 2 * DFF, (bf16_t*)(wb + WB_FI), DM, 0, r, 2 * DFF / 32, true, scr, lane); continue; } r -= I_FI;
        transpose_item(w_fo, DM, (bf16_t*)(wb + WB_FO), DFF, 0, r, DM / 32, false, scr, lane);
    }
    const float* wp = a.inp(10) + (size_t)l * 4 * 128 * 128; const float* psc = a.inp(11) + (size_t)l * 512; const float* wb1 = w_br + (size_t)512 * DM;
    bf16_t* WbT = (bf16_t*)(wb + WB_BR);
    for (int jt = gw; jt < (512 * (DM / 64) / 8) * np; jt += NGW) { const int it = (jt / np) * 8 + p_lo + jt % np;
        const int kc = it >> 4, n = (it & 15) * 64 + lane, g = kc >> 7; const float* wrow = wp + (size_t)kc * 128; const float* pss = psc + g * 128; const float* wbc = wb1 + (size_t)(g * 128) * DM + n;
        float s0 = 0.f, s1 = 0.f, s2 = 0.f, s3 = 0.f;
#pragma unroll 4
        for (int d = 0; d < 128; d += 4) {
            s0 += wrow[d] * pss[d] * wbc[(size_t)d * DM]; s1 += wrow[d + 1] * pss[d + 1] * wbc[(size_t)(d + 1) * DM];
            s2 += wrow[d + 2] * pss[d + 2] * wbc[(size_t)(d + 2) * DM]; s3 += wrow[d + 3] * pss[d + 3] * wbc[(size_t)(d + 3) * DM]; }
        WbT[(size_t)n * 1536 + 512 + kc] = (bf16_t)f2bf((s0 + s1) + (s2 + s3));
    }
}

DI void rowpass(const Cx& a, int mode, int l, int tid, int gw, int NGW) {
    const int lane = tid & 63;
    const float* MOD = (const float*)(a.ws + WS_MOD); const float* SS = (const float*)(a.ws + WS_SS); bf16_t* H = (bf16_t*)(a.ws + WS_H);
    bf16_t* XL = (bf16_t*)a.out; bf16_t* XCb = (bf16_t*)(a.ws + WS_XC); bf16_t* XA = (bf16_t*)(a.ws + WS_Z + 400 * MiB);
    const float* normg = a.inp(6); const float* xin = a.inp(0); const float* cin = a.inp(2);
    const int chunk = (ROWS + NGW - 1) / NGW; const int r0 = gw * chunk; const int r1 = (r0 + chunk < ROWS) ? r0 + chunk : ROWS;
    if (r0 >= r1) return;
    const bool lastl = (l == DEPTH - 1);
    const bool last = (mode == 2 && lastl);
    const bool skipc = (mode != 0 && lastl);
    const int l2 = (mode == 2) ? l + 1 : l; const int k2 = (mode == 1) ? 2 : 0;
    f32x4 gnv[4], g2v[4], gtv[4], shv[4], scv[4];
#pragma unroll
    for (int j = 0; j < 4; ++j) { const int c = 4 * lane + 256 * j;
        gnv[j] = (mode == 0) ? (f32x4){0.f, 0.f, 0.f, 0.f} : *(const f32x4*)(normg + ((size_t)l * 4 + (mode == 1 ? 1 : 3)) * DM + c);
        g2v[j] = last ? (f32x4){0.f, 0.f, 0.f, 0.f} : *(const f32x4*)(normg + ((size_t)l2 * 4 + k2) * DM + c);
        gtv[j] = (f32x4){0.f, 0.f, 0.f, 0.f}; shv[j] = gtv[j]; scv[j] = gtv[j]; }
    int cur_mv = -1;
    f32x4 xfc[4], xfn[4]; u32x2 xbc[4], xbn[4]; u32x2 yc[4], yn[4]; float sc_ = 0.f, sn_ = 0.f;
#define RP_XSRC(b_, n_) ((n_) < SEQ ? ((mode == 2 && lastl) ? XA : XL) + ((size_t)(b_) * SEQ + (n_)) * DM : XCb + ((size_t)(b_) * CTXL + ((n_) - SEQ)) * DM)
#define RP_XDST(b_, n_) ((n_) < SEQ ? ((mode == 1 && lastl) ? XA : XL) + ((size_t)(b_) * SEQ + (n_)) * DM : XCb + ((size_t)(b_) * CTXL + ((n_) - SEQ)) * DM)
#define RP_LOAD(row, XF, XB, Y, S_) do { const int b_ = (row) / NB, n_ = (row) - b_ * NB; \
        if (mode == 0) { const float* sp_ = (n_ < SEQ) ? xin + ((size_t)b_ * SEQ + n_) * DM : cin + ((size_t)b_ * CTXL + (n_ - SEQ)) * DM; \
            _Pragma("unroll") for (int j = 0; j < 4; ++j) XF[j] = *(const f32x4*)(sp_ + 4 * lane + 256 * j); } \
        else { const bf16_t* sp_ = RP_XSRC(b_, n_); \
            _Pragma("unroll") for (int j = 0; j < 4; ++j) { XB[j] = *(const u32x2*)(sp_ + 4 * lane + 256 * j); Y[j] = *(const u32x2*)(H + (size_t)(row) * DM + 4 * lane + 256 * j); } \
            S_ = SS[(size_t)(row) * 16 + (lane & 15)]; } } while (0)
    RP_LOAD(r0, xfc, xbc, yc, sc_);
    for (int row = r0; row < r1; ++row) {
        if (row + 1 < r1) RP_LOAD(row + 1, xfn, xbn, yn, sn_);
        const int b = row / NB, n = row - b * NB; const bool lat = n < SEQ; const int mv = lat ? b : 16;
        if (!(skipc && !lat)) {
            if (mv != cur_mv) { cur_mv = mv;
                const float* mb = MOD + ((size_t)l * NMOD + mv) * MODW; const float* mb2 = MOD + ((size_t)l2 * NMOD + mv) * MODW;
#pragma unroll
                for (int j = 0; j < 4; ++j) { const int c = 4 * lane + 256 * j;
                    if (mode != 0) gtv[j] = *(const f32x4*)(mb + (mode == 1 ? 2 * DM : 5 * DM) + c);
                    if (!last) { shv[j] = *(const f32x4*)(mb2 + (mode == 1 ? 3 * DM : 0) + c); scv[j] = *(const f32x4*)(mb2 + (mode == 1 ? 4 * DM : DM) + c); } } }
            f32x4 v[4];
            if (mode == 0) {
#pragma unroll
                for (int j = 0; j < 4; ++j) v[j] = xfc[j];
            } else {
                float ss = sc_;
                ss += __shfl_xor(ss, 1); ss += __shfl_xor(ss, 2); ss += __shfl_xor(ss, 4); ss += __shfl_xor(ss, 8);
                const float rstd = rsqrtf(ss * (1.f / DM) + EPS);
#pragma unroll
                for (int j = 0; j < 4; ++j) { f32x4 y, x; y[0] = bflo(yc[j].x); y[1] = bfhi(yc[j].x); y[2] = bflo(yc[j].y); y[3] = bfhi(yc[j].y);
                    x[0] = bflo(xbc[j].x); x[1] = bfhi(xbc[j].x); x[2] = bflo(xbc[j].y); x[3] = bfhi(xbc[j].y);
                    v[j] = x + gtv[j] * (y * rstd * gnv[j]); }
            }
            if (last) {
                float* op = a.out + ((size_t)b * SEQ + n) * DM;
#pragma unroll
                for (int j = 0; j < 4; ++j) *(f32x4*)(op + 4 * lane + 256 * j) = v[j];
            } else {
                bf16_t* xp = RP_XDST(b, n);
#pragma unroll
                for (int j = 0; j < 4; ++j) { u32x2 w; w.x = pk2c(v[j][0], v[j][1]); w.y = pk2c(v[j][2], v[j][3]); *(u32x2*)(xp + 4 * lane + 256 * j) = w; }
                float s2 = 0.f;
#pragma unroll
                for (int j = 0; j < 4; ++j) s2 += (v[j][0] * v[j][0] + v[j][1] * v[j][1]) + (v[j][2] * v[j][2] + v[j][3] * v[j][3]);
                const float rinv = rsqrtf(wave_sum(s2) * (1.f / DM) + EPS);
#pragma unroll
                for (int j = 0; j < 4; ++j) { const f32x4 h = v[j] * rinv * g2v[j] * (1.f + scv[j]) + shv[j]; u32x2 w; w.x = pk2c(h[0], h[1]); w.y = pk2c(h[2], h[3]);
                    *(u32x2*)(H + (size_t)row * DM + 4 * lane + 256 * j) = w; }
            }
        }
#pragma unroll
        for (int j = 0; j < 4; ++j) { xfc[j] = xfn[j]; xbc[j] = xbn[j]; yc[j] = yn[j]; }
        sc_ = sn_;
    }
#undef RP_XSRC
#undef RP_XDST
#undef RP_LOAD
}

DI void da_unit(const Cx& a, LAS unsigned char* lds, int l, int u, int N_DA_L) {
    int tid_ = threadIdx.x; asm volatile("" : "+v"(tid_));
    const int tid = tid_, lane = tid & 63, wave = tid >> 6, r32 = lane & 31, hi = lane >> 5;
    bf16_t* Z = (bf16_t*)(a.ws + WS_Z); bf16_t* H = (bf16_t*)(a.ws + WS_H);
    const float lam = ((const float*)(a.ws + WS_LAM))[l]; const float lam_init = 0.8f - 0.6f * expf(-0.3f * (float)l);
    int b, h, qb;
    if (u < N_DA_L) { b = u >> 6; h = (u >> 4) & 3; qb = u & 15; } else { const int c = u - N_DA_L; b = c >> 2; h = c & 3; qb = 16; }
    const bf16_t* Zb = Z + (size_t)b * NB * ZLD;
    const int q0 = qb * 256 + wave * 32;
    att::TileList tl; tl.a0 = (qb < 16) ? 0 : 64; tl.na = (qb < 16) ? 68 : 4; tl.b0 = 0; tl.nb = 0;
    float* stash = (float*)((unsigned char*)H + ((size_t)a.bx * 256 + wave * 32) * (DM * 2) + 1024);
    f32x16 o[4]; float lsum; float rli[16];
    att::attn_pass_pipe(lds, Zb, (size_t)q0 * ZLD + ZC_QA + h * 128, ZC_KA + h * 128, ZC_VA + h * 128, tl.a0, tl.na, o, lsum);
    att::row_rcp(lds, lsum, rli);
#pragma unroll
    for (int r = 0; r < 16; ++r)
#pragma unroll
        for (int d = 0; d < 4; ++d) stash[att::crow(r, hi) * 512 + d * 32 + r32] = o[d][r] * rli[r];
    att::attn_pass_pipe(lds, Zb, (size_t)q0 * ZLD + ZC_QA + h * 128 + 64, ZC_KA + h * 128 + 64, ZC_VA + h * 128, tl.a0, tl.na, o, lsum);
    att::row_rcp(lds, lsum, rli);
    const float* gsub = a.inp(9) + l * 128; const float g0 = gsub[r32], g1 = gsub[32 + r32], g2 = gsub[64 + r32], g3 = gsub[96 + r32]; const float post = 1.f - lam_init;
#pragma unroll
    for (int r = 0; r < 16; ++r) { const int rr = att::crow(r, hi); float v[4]; float sq = 0.f;
#pragma unroll
        for (int d = 0; d < 4; ++d) { v[d] = stash[rr * 512 + d * 32 + r32] - lam * (o[d][r] * rli[r]); sq += v[d] * v[d]; }
        sq += __shfl_xor(sq, 1); sq += __shfl_xor(sq, 2); sq += __shfl_xor(sq, 4); sq += __shfl_xor(sq, 8); sq += __shfl_xor(sq, 16);
        const float rn = rsqrtf(sq * (1.f / 128.f) + EPS) * post;
        bf16_t* op = Z + ((size_t)b * NB + q0 + rr) * ZLD + ZC_QA + h * 128 + r32;
        op[0] = (bf16_t)f2bf(v[0] * rn * g0); op[32] = (bf16_t)f2bf(v[1] * rn * g1); op[64] = (bf16_t)f2bf(v[2] * rn * g2); op[96] = (bf16_t)f2bf(v[3] * rn * g3); }
}
DI void wa_unit(const Cx& a, LAS unsigned char* lds, int l, int b, int kvh, int jq) {
    int tid_ = threadIdx.x; asm volatile("" : "+v"(tid_));
    const int tid = tid_, lane = tid & 63, wave = tid >> 6, r32 = lane & 31, hi = lane >> 5;
    bf16_t* Z = (bf16_t*)(a.ws + WS_Z);
    const bf16_t* Zb = Z + (size_t)b * NB * ZLD;
    const int head = kvh * 4 + (wave >> 1), q0 = jq * 64 + (wave & 1) * 32;
    att::TileList tl; tl.a0 = 64; tl.na = 4;
    if (jq < 64) { const int lo = jq - 2 < 0 ? 0 : jq - 2, hi_t = jq + 2 > 63 ? 63 : jq + 2; tl.b0 = lo; tl.nb = hi_t - lo + 1; } else { tl.b0 = 0; tl.nb = 0; }
    const float sink = a.inp(12)[l * 8 + head];
    f32x16 o[2]; float lsum; float rli[16];
    att::attn_pass<64, true>(lds, Zb, (size_t)q0 * ZLD + ZC_QW + head * 64, ZC_KW + kvh * 64, ZC_VW + kvh * 64, tl, jq, q0, sink * (1.f / att::SCALE), 1.f, o, lsum);
    att::row_rcp(lds, lsum, rli);
#pragma unroll
    for (int r = 0; r < 16; ++r) { bf16_t* op = Z + ((size_t)b * NB + q0 + att::crow(r, hi)) * ZLD + ZC_QW + head * 64 + r32;
        op[0] = (bf16_t)f2bf(o[0][r] * rli[r]); op[32] = (bf16_t)f2bf(o[1][r] * rli[r]); }
}
DI void pool_rows(const Cx& a, int l, int tid, int gw, int NGW) {
    const int lane = tid & 63;
    bf16_t* Z = (bf16_t*)(a.ws + WS_Z);
    const int chunk = (ROWS + NGW - 1) / NGW; const int r0 = gw * chunk; const int r1 = (r0 + chunk < ROWS) ? r0 + chunk : ROWS;
    if (r0 >= r1) return;
    const int g = lane >> 4, hw = 1 << g;
    const bf16_t* ucol = Z + ZC_U + lane * 8;
    float sum[8];
#pragma unroll
    for (int e = 0; e < 8; ++e) sum[e] = 0.f;
#define PL_LOAD(row, WA_, WR_, WS_) do { const int b_ = (row) / NB, n_ = (row) - b_ * NB; const bool lat_ = n_ < SEQ; const int t_ = lat_ ? n_ : n_ - SEQ, ns_ = lat_ ? SEQ : CTXL; const int rb_ = (row) - t_; \
        int ja_ = t_ + hw - 1; ja_ = ja_ < ns_ ? ja_ : ns_ - 1; int jr_ = t_ - 1 - hw; jr_ = jr_ < 0 ? 0 : jr_; \
        WA_ = *(const u32x4*)(ucol + (size_t)(rb_ + ja_) * ZLD); WR_ = *(const u32x4*)(ucol + (size_t)(rb_ + jr_) * ZLD); WS_ = *(const u32x4*)(ucol + (size_t)(row) * ZLD); } while (0)
#define PL_ACC(W, F) do { sum[0] += (F) * bflo(W.x); sum[1] += (F) * bfhi(W.x); sum[2] += (F) * bflo(W.y); sum[3] += (F) * bfhi(W.y); sum[4] += (F) * bflo(W.z); sum[5] += (F) * bfhi(W.z); sum[6] += (F) * bflo(W.w); sum[7] += (F) * bfhi(W.w); } while (0)
    u32x4 wa, wr, ws_, na, nr, ns;
    PL_LOAD(r0, wa, wr, ws_);
    bool need_init = true;
    for (int row = r0; row < r1; ++row) {
        if (row + 1 < r1) PL_LOAD(row + 1, na, nr, ns);
        const int b = row / NB, n = row - b * NB; const bool lat = n < SEQ; const int t = lat ? n : n - SEQ, nseq = lat ? SEQ : CTXL; const int rbase = row - t;
        if (l == DEPTH - 1 && !lat) { need_init = true; }
        else {
            const int lo = t - hw < 0 ? 0 : t - hw, hi_ = t + hw > nseq ? nseq : t + hw;
            if (need_init || t == 0) {
                need_init = false;
#pragma unroll
                for (int e = 0; e < 8; ++e) sum[e] = 0.f;
                u32x4 w[16];
#pragma unroll
                for (int jj = 0; jj < 16; ++jj) { int j = lo + jj; j = j < hi_ ? j : hi_ - 1; w[jj] = *(const u32x4*)(ucol + (size_t)(rbase + j) * ZLD); }
#pragma unroll
                for (int jj = 0; jj < 16; ++jj) { const float f = (lo + jj < hi_) ? 1.f : 0.f; PL_ACC(w[jj], f); }
            } else {
                const float fa = (t + hw - 1 < nseq) ? 1.f : 0.f, fr = (t - 1 - hw >= 0) ? -1.f : 0.f;
                PL_ACC(wa, fa); PL_ACC(wr, fr);
            }
            const float ic = 1.f / (float)(hi_ - lo);
            u32x4 o; o.x = pk2c(sum[0] * ic - bflo(ws_.x), sum[1] * ic - bfhi(ws_.x)); o.y = pk2c(sum[2] * ic - bflo(ws_.y), sum[3] * ic - bfhi(ws_.y));
            o.z = pk2c(sum[4] * ic - bflo(ws_.z), sum[5] * ic - bfhi(ws_.z)); o.w = pk2c(sum[6] * ic - bflo(ws_.w), sum[7] * ic - bfhi(ws_.w));
            *(u32x4*)(Z + (size_t)row * ZLD + ZC_PL + lane * 8) = o;
        }
        wa = na; wr = nr; ws_ = ns;
    }
#undef PL_LOAD
#undef PL_ACC
}

DI Cx make_cx(const Args& a0) {
    Cx c; GAS unsigned char* w = (GAS unsigned char*)a0.ws; GAS float* o = (GAS float*)a0.out; int G = gridDim.x, bx = blockIdx.x;
    asm volatile("" : "+s"(w), "+s"(o), "+s"(G), "+s"(bx));
    c.ws = (unsigned char*)w; c.out = (float*)o; c.G = G; c.bx = bx; c.vcu = (G % 8 == 0) ? (bx % 8) * (G / 8) + bx / 8 : bx;
    c.tab = (const float* const*)(c.ws + WS_TAB) + bx * 32;
    return c;
}
DI void phase0(const Cx& a, LAS unsigned char* lds) {
    int tid_ = threadIdx.x; asm volatile("" : "+v"(tid_));
    const int tid = tid_, lane = tid & 63, wave = tid >> 6, G = a.G, bx = a.bx;
    const int gw = a.vcu * 8 + wave, NGW = G * 8, gtid = bx * 512 + tid, NGT = G * 512;
    float* MOD = (float*)(a.ws + WS_MOD); float* ROPE = (float*)(a.ws + WS_ROPE); float* LAM = (float*)(a.ws + WS_LAM);
    LAS float* sl = (LAS float*)lds;
    LAS float* red = (LAS float*)(lds + 17 * 1024 * 4);
    const float* cvec = a.inp(1); const float* cctx = a.inp(3); const float* wada = a.inp(4); const float* bada = a.inp(5);
    bool filled = false;
    for (int it = bx; it < DEPTH * 96; it += G) {
        if (!filled) { for (int i = tid; i < NMOD * DM; i += 512) { const int v = i >> 10, k = i & 1023; const float c = (v < 16) ? cvec[v * DM + k] : cctx[k]; sl[i] = c * sigmoidf_(c); } filled = true; __syncthreads(); }
        const int l = it / 96, cb = it % 96, col = cb * 64 + lane;
        const float* wa = wada + (size_t)l * DM * MODW + col;
        float acc[NMOD];
#pragma unroll
        for (int v = 0; v < NMOD; ++v) acc[v] = 0.f;
        for (int k = wave * 128; k < wave * 128 + 128; k += 4) {
            const float w0 = wa[(size_t)k * MODW], w1 = wa[(size_t)(k + 1) * MODW], w2 = wa[(size_t)(k + 2) * MODW], w3 = wa[(size_t)(k + 3) * MODW];
#pragma unroll
            for (int v = 0; v < NMOD; ++v) { const f32x4 s = *(const LAS f32x4*)(sl + v * DM + k); acc[v] += (s[0] * w0 + s[1] * w1) + (s[2] * w2 + s[3] * w3); }
        }
#pragma unroll
        for (int v = 0; v < NMOD; ++v) red[(wave * NMOD + v) * 64 + lane] = acc[v];
        __syncthreads();
        for (int i = tid; i < NMOD * 64; i += 512) { const int v = i >> 6, ln = i & 63; float s = bada[(size_t)l * MODW + cb * 64 + ln];
#pragma unroll
            for (int w = 0; w < 8; ++w) s += red[(w * NMOD + v) * 64 + ln];
            MOD[((size_t)l * NMOD + v) * MODW + cb * 64 + ln] = s; }
        __syncthreads();
    }
    __syncthreads();
    for (int i = gtid; i < SEQ * 32; i += NGT) { const int n = i >> 5, f = i & 31; const float pos = (f < 16) ? (float)(n >> 6) : (float)(n & 63);
        const float inv = exp2f(-(float)(f & 15) * (13.287712379549449f / 16.f)); const float ang = pos * inv; ROPE[2 * i] = __cosf(ang); ROPE[2 * i + 1] = __sinf(ang); }
    if (bx == 0 && tid < DEPTH) { const float* lp = a.inp(8) + tid * 256; float s01 = 0.f, s23 = 0.f;
        for (int i = 0; i < 64; ++i) { s01 += lp[i] * lp[64 + i]; s23 += lp[128 + i] * lp[192 + i]; }
        LAM[tid] = __expf(s01) - __expf(s23) + (0.8f - 0.6f * __expf(-0.3f * (float)tid)); }
    conv_weights(a, 0, lds, tid, gw, NGW, 0, 8);
}
DI void phase_rows(const Cx& a, int mode, int l) { int tid_ = threadIdx.x; asm volatile("" : "+v"(tid_)); rowpass(a, mode, l, tid_, a.vcu * 8 + (tid_ >> 6), a.G * 8); }
DI void phase_conv(const Cx& a, int l, LAS unsigned char* lds, int p_lo, int p_hi) { int tid_ = threadIdx.x; asm volatile("" : "+v"(tid_));
    const int first = (a.G == 256) ? 64 : 0; if (a.bx < first) return;
    conv_weights(a, l, lds, tid_, (a.bx - first) * 8 + (tid_ >> 6), (a.G - first) * 8, p_lo, p_hi); }
DI void phase_attn(const Cx& a, LAS unsigned char* lds, int l) {
    constexpr int N_DA_L = NBATCH * 4 * 16;
    const bool lastl = (l == DEPTH - 1);
    for (int u = a.vcu; u < N_DA_L; u += a.G) da_unit(a, lds, l, u, N_DA_L);
    const int nstat = 7 * a.G;
    for (int w = a.vcu; w < nstat && w < 2048; w += a.G) wa_unit(a, lds, l, w >> 7, (w >> 6) & 1, w & 63);
    const int nDAc = lastl ? 0 : 64, nWL = (2048 > nstat) ? 2048 - nstat : 0, nWS = lastl ? 0 : 128, total = nDAc + nWL + nWS;
    unsigned* head = (unsigned*)(a.ws + WS_QCTR) + l * 64;
    volatile LAS unsigned* slot = (volatile LAS unsigned*)(lds + 131072 + 128);
    int tid_ = threadIdx.x; asm volatile("" : "+v"(tid_));
    unsigned nxt = 0u;
    if (tid_ == 0) nxt = __hip_atomic_fetch_add(head, 1u, __ATOMIC_RELAXED, __HIP_MEMORY_SCOPE_AGENT);
    for (;;) {
        __syncthreads();
        if (tid_ == 0) *slot = nxt;
        __syncthreads();
        const int idx = (int)*slot;
        if (idx >= total) break;
        if (tid_ == 0) nxt = __hip_atomic_fetch_add(head, 1u, __ATOMIC_RELAXED, __HIP_MEMORY_SCOPE_AGENT);
        if (idx < nDAc) da_unit(a, lds, l, N_DA_L + idx, N_DA_L);
        else if (idx < nDAc + nWL) { const int w = nstat + (idx - nDAc); wa_unit(a, lds, l, w >> 7, (w >> 6) & 1, w & 63); }
        else { const int s_ = idx - nDAc - nWL; wa_unit(a, lds, l, s_ >> 3, (s_ >> 2) & 1, 64 + (s_ & 3)); }
    }
}
DI void phase_pool(const Cx& a, int l) { int tid_ = threadIdx.x; asm volatile("" : "+v"(tid_)); pool_rows(a, l, tid_, a.vcu * 8 + (tid_ >> 6), a.G * 8); }
DI void phase_g1(const Cx& a, LAS unsigned char* lds, int l) {
    pg8::SchedPlain S; S.skipctx = false; S.T.init(ROWS / 256, INW / 256, a.G, a.bx); S.A = (const char*)(a.ws + WS_H); S.lda2 = DM * 2; S.B = (const char*)(a.ws + wb_off(l) + WB_IN); S.ldb2 = DM * 2;
    { int tid_ = threadIdx.x; asm volatile("" : "+v"(tid_)); const float* R = (const float*)(a.ws + WS_ROPE); LAS float* T = (LAS float*)(lds + 131072 + 1024);
      for (int e = tid_; e < 64 * 16; e += 512) { const int pos = e >> 4, f = e & 15; T[2 * e] = R[((size_t)pos * 32 + 16 + f) * 2]; T[2 * e + 1] = R[((size_t)pos * 32 + 16 + f) * 2 + 1]; }
      __syncthreads(); }
    pg8::EpiIn E{(bf16_t*)(a.ws + WS_Z), (const LAS float*)(lds + 131072 + 1024)}; pg8::gemm_phase(lds, DM * 2, DM * 2, DM / 64, S, E); }
DI void phase_g2(const Cx& a, LAS unsigned char* lds, int l) {
    pg8::SchedMerge S; S.skipctx = (l == DEPTH - 1); S.T.init(S.skipctx ? 256 : ROWS / 256, DM / 256, a.G, a.bx); S.Z = (const char*)(a.ws + WS_Z); S.H = (const char*)(a.ws + WS_H); S.Wb = (const char*)(a.ws + wb_off(l) + WB_BR);
    pg8::EpiMerge E{(bf16_t*)(a.ws + WS_Z)}; pg8::gemm_phase(lds, ZLD * 2, 1536 * 2, 512 / 64, S, E); }
DI void phase_g3(const Cx& a, LAS unsigned char* lds, int l) {
    pg8::SchedPlain S; S.skipctx = (l == DEPTH - 1); S.T.init(S.skipctx ? 256 : ROWS / 256, DM / 256, a.G, a.bx); S.A = (const char*)(a.ws + WS_Z + ZC_M * 2); S.lda2 = ZLD * 2; S.B = (const char*)(a.ws + wb_off(l) + WB_O); S.ldb2 = DM * 2;
    pg8::EpiOut E{(bf16_t*)(a.ws + WS_H), (float*)(a.ws + WS_SS)}; pg8::gemm_phase(lds, ZLD * 2, DM * 2, DM / 64, S, E); }
DI void phase_g4(const Cx& a, LAS unsigned char* lds, int l) {
    pg8::SchedPlain S; S.skipctx = (l == DEPTH - 1); S.T.init(S.skipctx ? 256 : ROWS / 256, 2 * DFF / 256, a.G, a.bx); S.A = (const char*)(a.ws + WS_H); S.lda2 = DM * 2; S.B = (const char*)(a.ws + wb_off(l) + WB_FI); S.ldb2 = DM * 2;
    pg8::EpiFfn E{(bf16_t*)(a.ws + WS_Z)}; pg8::gemm_phase(lds, DM * 2, DM * 2, DM / 64, S, E); }
DI void phase_g5(const Cx& a, LAS unsigned char* lds, int l) {
    pg8::SchedPlain S; S.skipctx = (l == DEPTH - 1); S.T.init(S.skipctx ? 256 : ROWS / 256, DM / 256, a.G, a.bx); S.T.rev = true; S.A = (const char*)(a.ws + WS_Z); S.lda2 = DFF * 2; S.B = (const char*)(a.ws + wb_off(l) + WB_FO); S.ldb2 = DFF * 2;
    pg8::EpiOut E{(bf16_t*)(a.ws + WS_H), (float*)(a.ws + WS_SS)}; pg8::gemm_phase(lds, DFF * 2, DFF * 2, DFF / 64, S, E); }

#ifndef PHM
#define PHM 0xFFFF
#endif
__global__ void __launch_bounds__(512, 2) fwd_kernel(Args a0) {
    extern __shared__ __attribute__((aligned(16))) unsigned char lds_raw[];
    LAS unsigned char* lds = (LAS unsigned char*)lds_raw;
    cg::grid_group grid = cg::this_grid();
    if (threadIdx.x == 0) {
        const float** t = (const float**)(a0.ws + WS_TAB) + blockIdx.x * 32;
        t[0] = a0.in[0]; t[1] = a0.in[1]; t[2] = a0.in[2]; t[3] = a0.in[3]; t[4] = a0.in[4]; t[5] = a0.in[5]; t[6] = a0.in[6]; t[7] = a0.in[7]; t[8] = a0.in[8];
        t[9] = a0.in[9]; t[10] = a0.in[10]; t[11] = a0.in[11]; t[12] = a0.in[12]; t[13] = a0.in[13]; t[14] = a0.in[14]; t[15] = a0.in[15]; t[16] = a0.in[16];
        __threadfence();
    }
    __syncthreads();
    volatile LAS unsigned* xst = (volatile LAS unsigned*)(lds + 131072 + 64);
    if (threadIdx.x < 2) xst[threadIdx.x] = 0u;
    if (blockIdx.x == 0) { unsigned* bw = (unsigned*)(a0.ws + WS_BAR); for (int i = threadIdx.x; i < XCD_BAR_WORDS; i += 512) bw[i] = 0u; }
    if (blockIdx.x == 0 && threadIdx.x < DEPTH) ((unsigned*)(a0.ws + WS_QCTR))[threadIdx.x * 64] = 0u;
    if (PHM & 1) { const Cx a = make_cx(a0); phase0(a, lds); }
    grid.sync();
    if (threadIdx.x == 0) (void)xb_add((unsigned*)(a0.ws + WS_BAR) + XB_XCNT(xb_xcc_id()), 1u);
#define GSYNC() xcd_barrier((unsigned*)(a0.ws + WS_BAR), xst)
    if (PHM & 2) { const Cx a = make_cx(a0); phase_rows(a, 0, 0); }
    GSYNC();
#pragma unroll 1
    for (int l = 0; l < DEPTH; ++l) {
        if (PHM & 4) { const Cx a = make_cx(a0); phase_g1(a, lds, l); }
        GSYNC();
        if (PHM & 8) { const Cx a = make_cx(a0); phase_attn(a, lds, l); }
        GSYNC();
        if (PHM & 2048) { const Cx a = make_cx(a0); phase_pool(a, l); }
        GSYNC();
        if (PHM & 16) { const Cx a = make_cx(a0); phase_g2(a, lds, l); if (l + 1 < DEPTH) phase_conv(a, l + 1, lds, 0, 5); }
        GSYNC();
        if (PHM & 32) { const Cx a = make_cx(a0); phase_g3(a, lds, l); }
        GSYNC();
        if (PHM & 64) { const Cx a = make_cx(a0); phase_rows(a, 1, l); }
        GSYNC();
        if (PHM & 128) { const Cx a = make_cx(a0); phase_g4(a, lds, l); }
        GSYNC();
        if (PHM & 256) { const Cx a = make_cx(a0); phase_g5(a, lds, l); if (l + 1 < DEPTH) phase_conv(a, l + 1, lds, 5, 8); }
        GSYNC();
        if (PHM & 512) { const Cx a = make_cx(a0); phase_rows(a, 2, l); }
        if (l + 1 < DEPTH) GSYNC();
    }
}

extern "C" void kernel_launch(void* const* d_in, const int* in_sizes, int n_in, void* d_out, int out_size, void* d_ws, size_t ws_size, hipStream_t stream) {
    static int grid = 0;
    if (grid == 0) {
        if (n_in != 17 || out_size != NBATCH * SEQ * DM || ws_size < WS_END) { fprintf(stderr, "kernel_launch: unexpected shapes (n_in %d out %d ws %zu, need ws >= %zu)\n", n_in, out_size, ws_size, (size_t)WS_END); grid = -1; return; }
        int dev = 0, cus = 0, per = 0;
        hipGetDevice(&dev); hipDeviceGetAttribute(&cus, hipDeviceAttributeMultiprocessorCount, dev);
        if (hipFuncSetAttribute((const void*)fwd_kernel, hipFuncAttributeMaxDynamicSharedMemorySize, LDS_BYTES) != hipSuccess) { fprintf(stderr, "kernel_launch: hipFuncSetAttribute failed\n"); grid = -1; return; }
        hipOccupancyMaxActiveBlocksPerMultiprocessor(&per, (const void*)fwd_kernel, 512, LDS_BYTES);
        (void)hipGetLastError();
        if (per < 1) { fprintf(stderr, "kernel_launch: occupancy query says %d blocks per CU\n", per); per = 1; }
        grid = cus;
        if (grid > 256) grid = 256;
    }
    if (grid < 0) return;
    Args a{};
    for (int i = 0; i < 17; ++i) a.in[i] = (const float*)d_in[i];
    a.out = (float*)d_out; a.ws = (unsigned char*)d_ws;
    void* args[] = {&a};
    hipError_t e = hipLaunchCooperativeKernel((const void*)fwd_kernel, dim3(grid), dim3(512), args, LDS_BYTES, stream);
    if (e != hipSuccess) fprintf(stderr, "kernel_launch: cooperative launch failed: %s (grid %d)\n", hipGetErrorString(e), grid);
}
```

```cpp
#include <hip/hip_runtime.h>
#include <hip/hip_cooperative_groups.h>
#include <cstdio>
#include <cstdint>
namespace cg = cooperative_groups;

#define LAS __attribute__((address_space(3)))
typedef unsigned short bf16_t;
typedef short bf16x8 __attribute__((ext_vector_type(8)));
typedef short s16x4 __attribute__((ext_vector_type(4)));
typedef float f32x4 __attribute__((ext_vector_type(4)));
typedef float f32x16 __attribute__((ext_vector_type(16)));
typedef unsigned u32x4 __attribute__((ext_vector_type(4)));
typedef unsigned u32x2 __attribute__((ext_vector_type(2)));
#define DI __device__ __forceinline__
#define GAS __attribute__((address_space(1)))

constexpr int NBATCH = 16, SEQ = 4096, CTXL = 256, NB = SEQ + CTXL  , ROWS = NBATCH * NB  ;
constexpr int DM = 1024, DEPTH = 4, INW = 5888, DFF = 2816, ZLD = INW, MODW = 6 * DM, NMOD = 17;
constexpr float EPS = 1e-6f;
constexpr int ZC_QA = 0, ZC_KA = 512, ZC_VA = 1024, ZC_U = 1536, ZC_QW = 2048, ZC_KW = 2560, ZC_VW = 2688, ZC_G = 2816, ZC_M = 1024, ZC_PL = 512;
constexpr size_t MiB = 1u << 20;
constexpr size_t WS_LAM = 0, WS_TAB = 4096, WS_BAR = 128 * 1024, WS_QCTR = 192 * 1024, WS_MOD = 1 * MiB, WS_ROPE = 3 * MiB, WS_SS = 4 * MiB, WS_WB = 9 * MiB, WS_XC = 42 * MiB, WS_H = 58 * MiB, WS_Z = 194 * MiB, WS_WB2 = 976 * MiB, WS_END = 1010 * MiB;
constexpr size_t WB_IN = 0, WB_BR = (size_t)INW * DM * 2, WB_O = WB_BR + (size_t)DM * 1536 * 2, WB_FI = WB_O + (size_t)DM * DM * 2, WB_FO = WB_FI + (size_t)2 * DFF * DM * 2, WB_END = WB_FO + (size_t)DM * DFF * 2;
static_assert(WS_WB + WB_END <= WS_XC && WS_H + (size_t)ROWS * DM * 2 <= WS_Z && WS_Z + (size_t)ROWS * ZLD * 2 <= WS_WB2 && WS_WB2 + WB_END <= WS_END, "ws map");
__device__ __forceinline__ size_t wb_off(int l) { return (l & 1) ? WS_WB2 : WS_WB; }
constexpr int LDS_BYTES = 147456;

struct Args { const float* in[17]; float* out; unsigned char* ws; };
struct Cx { unsigned char* ws; float* out; const float* const* tab; int G, bx, vcu; __device__ __forceinline__ const float* inp(int i) const { return (const float*)(const GAS float*)tab[i]; } };

DI unsigned f2bf(float f) { unsigned u = __float_as_uint(f); return (u + 0x7fffu + ((u >> 16) & 1u)) >> 16; }
DI unsigned pk2(float lo, float hi) { return f2bf(lo) | (f2bf(hi) << 16); }
DI unsigned pk2c(float lo, float hi) { unsigned r; asm("v_cvt_pk_bf16_f32 %0, %1, %2" : "=v"(r) : "v"(lo), "v"(hi)); return r; }
DI float bflo(unsigned w) { return __uint_as_float(w << 16); }
DI float bfhi(unsigned w) { return __uint_as_float(w & 0xffff0000u); }
DI float wave_sum(float v) {
#pragma unroll
    for (int o = 1; o < 64; o <<= 1) v += __shfl_xor(v, o);
    return v;
}
DI float sigmoidf_(float x) { return __builtin_amdgcn_rcpf(1.f + __expf(-x)); }


#define XB_TMO      128
#define XB_XCNT(j)  (256  + 64 * (j))
#define XB_XSUB(j)  (1280 + 64 * (j))
#define XB_XGEN(j)  (2304 + 64 * (j))
#define XB_TOP      3328
#define XB_TOPGEN   3392
#define XCD_BAR_WORDS 3456
#define XB_SPIN_CAP (1u << 18)
DI unsigned xb_ld(unsigned* p)              { return __hip_atomic_load(p, __ATOMIC_RELAXED, __HIP_MEMORY_SCOPE_AGENT); }
DI unsigned xb_add(unsigned* p, unsigned v) { return __hip_atomic_fetch_add(p, v, __ATOMIC_RELAXED, __HIP_MEMORY_SCOPE_AGENT); }
DI unsigned xb_xcc_id() { return (unsigned)__builtin_amdgcn_s_getreg((3 << 11) | 20) & 0xFu; }
#define XB_SPIN(cond, bar) do { unsigned _sp = 0; while (cond) { __builtin_amdgcn_s_sleep(1); \
    if ((++_sp & 255u) == 0u) { if (xb_ld(&(bar)[XB_TMO])) break; if (_sp > XB_SPIN_CAP) { atomicAdd(&(bar)[XB_TMO], 1u); break; } } } } while (0)
DI void xcd_barrier_complete(unsigned* bar, unsigned x, unsigned& nloc, unsigned& nx) {
    const unsigned G = gridDim.x * gridDim.y * gridDim.z;
    unsigned sum, cnt, mine, sp = 0u;
    for (;;) {
        sum = 0u; cnt = 0u; mine = 0u;
#pragma unroll
        for (unsigned j = 0; j < 16; ++j) { const unsigned c = xb_ld(&bar[XB_XCNT(j)]); sum += c; cnt += (c > 0u) ? 1u : 0u; mine = (j == x) ? c : mine; }
        if (sum == G) break;
        __builtin_amdgcn_s_sleep(1);
        if ((++sp & 255u) == 0u) { if (xb_ld(&bar[XB_TMO])) break; if (sp > XB_SPIN_CAP) { atomicAdd(&bar[XB_TMO], 1u); break; } }
    }
    nloc = mine > 0u ? mine : 1u; nx = cnt > 0u ? cnt : 1u;
}
DI void xcd_barrier(unsigned* bar, volatile LAS unsigned* st) {
    asm volatile("s_waitcnt vmcnt(0)" ::: "memory");
    __syncthreads();
    if (threadIdx.x == 0) {
        const unsigned x = xb_xcc_id();
        __builtin_amdgcn_s_waitcnt(0);
        unsigned nloc = st[0], nx = st[1];
        if (nloc == 0u) { xcd_barrier_complete(bar, x, nloc, nx); st[0] = nloc; st[1] = nx; }
        const unsigned old = xb_add(&bar[XB_XSUB(x)], 1u);
        const unsigned gen = old / nloc;
        if (old + 1u == (gen + 1u) * nloc) {
            __builtin_amdgcn_fence(__ATOMIC_RELEASE, "agent");
            asm volatile("s_waitcnt vmcnt(0)" ::: "memory");
            const unsigned og = xb_add(&bar[XB_TOP], 1u);
            const unsigned tg = og / nx;
            if (og + 1u == (tg + 1u) * nx) xb_add(&bar[XB_TOPGEN], 1u);
            else XB_SPIN(xb_ld(&bar[XB_TOPGEN]) == tg, bar);
            __builtin_amdgcn_fence(__ATOMIC_ACQUIRE, "agent");
            xb_add(&bar[XB_XGEN(x)], 1u);
            asm volatile("s_waitcnt vmcnt(0)" ::: "memory");
        } else {
            XB_SPIN(xb_ld(&bar[XB_XGEN(x)]) == gen, bar);
            __builtin_amdgcn_fence(__ATOMIC_ACQUIRE, "agent");
            asm volatile("s_waitcnt vmcnt(0)" ::: "memory");
        }
    }
    __syncthreads();
}

namespace pg8 {
constexpr int BM = 256, BK = 64, HALF = 128, HTB = HALF * BK * 2, STAGE_BYTES = 8 * HTB, NXCD = 8, WGM = 8;
DI int lds_byte(int r, int c) { const int st = (r >> 4) * 2 + (c >> 5), rr = r & 15, cc = c & 31, ob = rr * 64 + cc * 2; return st * 1024 + (ob ^ (((ob >> 9) & 1) << 5)); }
DI void stage_rc(int b, int& R, int& C) { const int st = b / 1024, sb = b % 1024, swz = sb ^ (((sb >> 9) & 1) << 5); R = (st >> 1) * 16 + swz / 64; C = (st & 1) * 32 + (swz % 64) / 2; }

DI int perm32(int rho) { const int n = rho >> 4, i = rho & 15; return 8 * (i >> 2) + 4 * n + (i & 3); }

struct Unit { const char* A; const char* B; int lda2; int pm, pn, br; };

struct TileOrder {
    int nM, nN, nwg, G, c; bool rev = false;
    DI void init(int nM_, int nN_, int G_, int c_) { nM = nM_; nN = nN_; nwg = nM * nN; G = G_; c = c_; }
    DI bool tile(int i, int& pm, int& pn) const {
        const long L = (long)i * G + c; if (L >= nwg) return false;
        int wgid = (int)L; { const int q = nwg / NXCD, r = nwg % NXCD, xcd = wgid % NXCD; int off = wgid / NXCD; if (rev) off = (xcd < r ? q : q - 1) - off; wgid = (xcd < r ? xcd * (q + 1) : r * (q + 1) + (xcd - r) * q) + off; }
        const int nig = WGM * nN, gid = wgid / nig, fm = gid * WGM, gsz = (nM - fm) < WGM ? (nM - fm) : WGM;
        pm = fm + ((wgid % nig) % gsz); pn = (wgid % nig) / gsz; return true;
    }
};
struct SchedPlain {
    TileOrder T; const char* A; int lda2; const char* B; int ldb2; bool skipctx;
    int ctxkv = 0;
    DI bool next(int i, Unit& u) const { int pm, pn;
        if (!T.tile(i, pm, pn)) { const long j = (long)i * T.G + T.c - T.nwg; if (ctxkv == 0 || j < 0 || j >= ctxkv) return false;
            const int p = (int)j / 5, t = (int)j - 5 * p; pm = 17 * p + 16; pn = (t == 4) ? 10 : 2 + t; }
        else if (skipctx) pm += pm >> 4;
        u.A = A + (size_t)pm * 256 * lda2; u.B = B + (size_t)pn * 256 * ldb2; u.lda2 = lda2; u.pm = pm; u.pn = pn; u.br = 0; return true; }
};
struct SchedMerge {
    TileOrder T; const char* Z; const char* H; const char* Wb; bool skipctx;
    DI bool next(int i, Unit& u) const { const int it = i / 3, br = i - 3 * it; int pm, pn; if (!T.tile(it, pm, pn)) return false; if (skipctx) pm += pm >> 4;
        u.A = Z + (size_t)pm * 256 * (ZLD * 2) + (br == 0 ? ZC_QA * 2 : (br == 1 ? ZC_PL * 2 : ZC_QW * 2)); u.lda2 = ZLD * 2;
        u.B = Wb + (size_t)pn * 256 * (1536 * 2) + br * 1024; u.pm = pm; u.pn = pn; u.br = br; return true; }
};

template <class Epi, class Sched>
DI void gemm_phase(LAS unsigned char* lds, const int lda2, const int ldb2, const int nt, const Sched& S, const Epi& E) {
    int tid_ = threadIdx.x; asm volatile("" : "+v"(tid_));
    const int tid = tid_, wid = __builtin_amdgcn_readfirstlane(tid >> 6), lane = tid & 63, wr = wid >> 2, wc = wid & 3, fr = lane & 15, fq = lane >> 4;
    int R0, C0, R1, C1; stage_rc(tid * 16, R0, C0); stage_rc(tid * 16 + 8192, R1, C1);
    const int Rb0 = (R0 & ~31) + perm32(R0 & 31), Rb1 = (R1 & ~31) + perm32(R1 & 31);
    const unsigned vB0 = (unsigned)(Rb0 * ldb2 + C0 * 2), vB1 = (unsigned)(Rb1 * ldb2 + C1 * 2);
    const size_t kstep = (size_t)(BK * 2);
    const size_t hstepB = (size_t)HALF * ldb2;
    const unsigned ldsw = (unsigned)wid * 1024u;
    const int aoff = lds_byte(wr * 64 + fr, fq * 8), boff = lds_byte(wc * 32 + fr, fq * 8);
#define PG8_SA(b, h) (((b) * 2 + (h)) * HTB)
#define PG8_SB(b, h) ((4 + (b) * 2 + (h)) * HTB)
#define PG8_STAGE(bufoff, gbase, V0, V1) do { \
        __builtin_amdgcn_global_load_lds((const unsigned*)((const char*)(gbase) + (V0)), (LAS unsigned*)(lds + (bufoff) + ldsw), 16, 0, 0); \
        __builtin_amdgcn_global_load_lds((const unsigned*)((const char*)(gbase) + (V1)), (LAS unsigned*)(lds + (bufoff) + ldsw + 8192), 16, 0, 0); } while (0)
#define PG8_LDA(dst, b, h) do { _Pragma("unroll") for (int m = 0; m < 4; ++m) _Pragma("unroll") for (int k = 0; k < 2; ++k) dst[m][k] = *(const LAS bf16x8*)(lds + PG8_SA(b, h) + aoff + m * 2048 + k * 1024); } while (0)
#define PG8_LDB(dst, b, h) do { _Pragma("unroll") for (int n = 0; n < 2; ++n) _Pragma("unroll") for (int k = 0; k < 2; ++k) dst[n][k] = *(const LAS bf16x8*)(lds + PG8_SB(b, h) + boff + n * 2048 + k * 1024); } while (0)
#define PG8_MMA(ai, bj, At, Bt) do { __builtin_amdgcn_s_setprio(1); _Pragma("unroll") for (int m = 0; m < 4; ++m) _Pragma("unroll") for (int n = 0; n < 2; ++n) _Pragma("unroll") for (int k = 0; k < 2; ++k) \
        acc[ai][bj][m][n] = __builtin_amdgcn_mfma_f32_16x16x32_bf16(Bt[n][k], At[m][k], acc[ai][bj][m][n], 0, 0, 0); __builtin_amdgcn_s_setprio(0); } while (0)
#define PG8_WAIT_V(n) asm volatile("s_waitcnt vmcnt(" #n ")" ::: "memory")
#define PG8_WAIT_L(n) asm volatile("s_waitcnt lgkmcnt(" #n ")" ::: "memory")
#define PG8_BAR __builtin_amdgcn_s_barrier()
#define PG8_SCHED __builtin_amdgcn_sched_barrier(0)
    Unit cur, nxt; int ui = 0;
    if (!S.next(0, cur)) return;
    f32x4 acc[2][2][4][2];
#pragma unroll
    for (int a = 0; a < 2; ++a)
#pragma unroll
        for (int b = 0; b < 2; ++b)
#pragma unroll
            for (int m = 0; m < 4; ++m)
#pragma unroll
                for (int n = 0; n < 2; ++n) acc[a][b][m][n] = (f32x4){0.f, 0.f, 0.f, 0.f};
    bf16x8 At[4][2], B0[2][2], B1[2][2];
    const char* cA = cur.A; const char* cB = cur.B;
    const unsigned vA0 = (unsigned)(R0 * lda2 + C0 * 2), vA1 = (unsigned)(R1 * lda2 + C1 * 2); const size_t hstepA = (size_t)HALF * lda2;
    PG8_STAGE(PG8_SB(0, 0), cB, vB0, vB1); PG8_STAGE(PG8_SB(0, 1), cB + hstepB, vB0, vB1); PG8_STAGE(PG8_SA(0, 0), cA, vA0, vA1); PG8_STAGE(PG8_SA(0, 1), cA + hstepA, vA0, vA1);
    if (wr == 1) PG8_BAR;
    PG8_WAIT_V(2); PG8_BAR;
    PG8_STAGE(PG8_SB(1, 0), cB + kstep, vB0, vB1); PG8_STAGE(PG8_SA(1, 0), cA + kstep, vA0, vA1); PG8_STAGE(PG8_SB(1, 1), cB + hstepB + kstep, vB0, vB1);
    PG8_WAIT_V(6); PG8_BAR;
    for (;;) {
        const bool has_next = S.next(ui + 1, nxt);
        const char* nA = has_next ? nxt.A : cA; const char* nB = has_next ? nxt.B : cB;
        for (int t = 0; t < nt; t += 2) {
            const bool last = (t == nt - 2);
            const char* a1 = cA + (size_t)(t + 1) * kstep;
            const char* a2 = last ? nA : cA + (size_t)(t + 2) * kstep; const char* b2 = last ? nB : cB + (size_t)(t + 2) * kstep;
            const char* a3 = a2 + kstep; const char* b3 = b2 + kstep;
            PG8_LDB(B0, 0, 0); PG8_LDB(B1, 0, 1); PG8_SCHED; PG8_LDA(At, 0, 0); PG8_STAGE(PG8_SA(1, 1), a1 + hstepA, vA0, vA1);
            PG8_WAIT_V(8); PG8_WAIT_L(0); PG8_BAR; PG8_MMA(0, 0, At, B0); PG8_MMA(0, 1, At, B1); PG8_BAR; PG8_SCHED;
            PG8_LDA(At, 0, 1); PG8_STAGE(PG8_SB(0, 0), b2, vB0, vB1); PG8_STAGE(PG8_SB(0, 1), b2 + hstepB, vB0, vB1); PG8_STAGE(PG8_SA(0, 0), a2, vA0, vA1);
            PG8_WAIT_V(8); PG8_WAIT_L(0); PG8_BAR; PG8_MMA(1, 0, At, B0); PG8_MMA(1, 1, At, B1); PG8_BAR; PG8_SCHED;
            PG8_LDB(B0, 1, 0); PG8_LDB(B1, 1, 1); PG8_SCHED; PG8_LDA(At, 1, 0); PG8_STAGE(PG8_SA(0, 1), a2 + hstepA, vA0, vA1);
            PG8_WAIT_V(8); PG8_WAIT_L(0); PG8_BAR; PG8_MMA(0, 0, At, B0); PG8_MMA(0, 1, At, B1); PG8_BAR; PG8_SCHED;
            PG8_LDA(At, 1, 1); PG8_STAGE(PG8_SB(1, 0), b3, vB0, vB1); PG8_STAGE(PG8_SB(1, 1), b3 + hstepB, vB0, vB1); PG8_STAGE(PG8_SA(1, 0), a3, vA0, vA1);
            PG8_WAIT_V(8); PG8_WAIT_L(0); PG8_BAR; PG8_MMA(1, 0, At, B0); PG8_MMA(1, 1, At, B1); PG8_BAR; PG8_SCHED;
        }
        if (wr == 0) PG8_BAR;
        asm volatile("s_nop 7\n\ts_nop 7\n\ts_nop 3" ::: "memory");
        E(acc, cur, wr, wc, fr, fq);
        if (!has_next) break;
        if (E.reset(cur)) {
#pragma unroll
        for (int a = 0; a < 2; ++a)
#pragma unroll
            for (int b = 0; b < 2; ++b)
#pragma unroll
                for (int m = 0; m < 4; ++m)
#pragma unroll
                    for (int n = 0; n < 2; ++n) acc[a][b][m][n] = (f32x4){0.f, 0.f, 0.f, 0.f};
        }
        cur = nxt; cA = nA; cB = nB; ++ui;
        if (wr == 1) PG8_BAR;
    }
    PG8_WAIT_V(0);
    PG8_BAR;
#undef PG8_SA
#undef PG8_SB
#undef PG8_STAGE
#undef PG8_LDA
#undef PG8_LDB
#undef PG8_MMA
#undef PG8_WAIT_V
#undef PG8_WAIT_L
#undef PG8_BAR
#undef PG8_SCHED
}

typedef f32x4 AccT[2][2][4][2];
struct EpiIn {
    bf16_t* Z; const LAS float* ropeT;
    DI bool reset(const Unit&) const { return true; }
    DI void operator()(AccT& acc, const Unit& u, int wr, int wc, int fr, int fq) const {
        asm volatile("" : "+v"(fr), "+v"(fq));
        const int pn = u.pn, pmb = u.pm % 17; const bool lat = pmb != 16;
        const bool gate = pn >= 11;
        const bool ropet = lat && (pn <= 3 || (pn >= 8 && pn <= 10));
#pragma unroll
        for (int ai = 0; ai < 2; ++ai)
#pragma unroll
            for (int m = 0; m < 4; ++m) {
                const int rt = ai * 128 + wr * 64 + m * 16 + fr; const size_t row = (size_t)u.pm * 256 + rt; const int npos = pmb * 256 + rt;
#pragma unroll
                for (int bj = 0; bj < 2; ++bj) {
                    const int col = pn * 256 + bj * 128 + wc * 32 + 8 * fq; f32x4 v0 = acc[ai][bj][m][0], v1 = acc[ai][bj][m][1];
                    if (gate) {
#pragma unroll
                        for (int e = 0; e < 4; ++e) { v0[e] = sigmoidf_(v0[e]); v1[e] = sigmoidf_(v1[e]); }
                    } else if (ropet && !(pn == 10 && bj == 1)) {
                        const int i_ = (col & 63) >> 1; const int pos_ = (i_ < 16) ? (npos >> 6) : (npos & 63);
                        const LAS float* tp = ropeT + (pos_ * 16 + (i_ & 15)) * 2;
                        const f32x4 T0 = *(const LAS f32x4*)tp, T1 = *(const LAS f32x4*)(tp + 4), T2 = *(const LAS f32x4*)(tp + 8), T3 = *(const LAS f32x4*)(tp + 12);
                        f32x4 a, b;
                        a[0] = v0[0] * T0[0] - v0[1] * T0[1]; a[1] = v0[0] * T0[1] + v0[1] * T0[0]; a[2] = v0[2] * T0[2] - v0[3] * T0[3]; a[3] = v0[2] * T0[3] + v0[3] * T0[2];
                        b[0] = v1[0] * T1[0] - v1[1] * T1[1]; b[1] = v1[0] * T1[1] + v1[1] * T1[0]; b[2] = v1[2] * T1[2] - v1[3] * T1[3]; b[3] = v1[2] * T1[3] + v1[3] * T1[2];
                        v0 = a; v1 = b; (void)T2; (void)T3;
                    } else { v0 = v0 + 0.f; v1 = v1 + 0.f; }
                    u32x4 w; w.x = pk2c(v0[0], v0[1]); w.y = pk2c(v0[2], v0[3]); w.z = pk2c(v1[0], v1[1]); w.w = pk2c(v1[2], v1[3]);
                    *(u32x4*)(Z + row * ZLD + col) = w;
                }
            }
    }
};
struct EpiMerge {
    bf16_t* Z;
    DI bool reset(const Unit& u) const { return u.br == 2; }
    DI void operator()(AccT& acc, const Unit& u, int wr, int wc, int fr, int fq) const {
        asm volatile("" : "+v"(fr), "+v"(fq));
        const int br = u.br;
#pragma unroll
        for (int ai = 0; ai < 2; ++ai) {
            u32x4 ga[4][2], gb[4][2];
#pragma unroll
            for (int m = 0; m < 4; ++m) { const size_t row = (size_t)u.pm * 256 + ai * 128 + wr * 64 + m * 16 + fr;
#pragma unroll
                for (int bj = 0; bj < 2; ++bj) { const bf16_t* gp = Z + row * ZLD + ZC_G + br * 1024 + u.pn * 256 + bj * 128 + wc * 32 + 8 * fq;
                    ga[m][bj] = *(const u32x4*)gp; gb[m][bj] = (br < 2) ? *(const u32x4*)(gp + 1024) : (u32x4){0x3f803f80u, 0x3f803f80u, 0x3f803f80u, 0x3f803f80u}; } }
            __builtin_amdgcn_sched_barrier(0);
#pragma unroll
            for (int m = 0; m < 4; ++m) { const size_t row = (size_t)u.pm * 256 + ai * 128 + wr * 64 + m * 16 + fr;
#pragma unroll
                for (int bj = 0; bj < 2; ++bj) { const int col = u.pn * 256 + bj * 128 + wc * 32 + 8 * fq;
                    const u32x4 gw = ga[m][bj], hw = gb[m][bj];
                    f32x4 g0, g1;
                    g0[0] = fmaxf(bflo(gw.x), 1e-18f); g0[1] = fmaxf(bfhi(gw.x), 1e-18f); g0[2] = fmaxf(bflo(gw.y), 1e-18f); g0[3] = fmaxf(bfhi(gw.y), 1e-18f);
                    g1[0] = fmaxf(bflo(gw.z), 1e-18f); g1[1] = fmaxf(bfhi(gw.z), 1e-18f); g1[2] = fmaxf(bflo(gw.w), 1e-18f); g1[3] = fmaxf(bfhi(gw.w), 1e-18f);
                    if (br < 2) {
                        g0[0] *= __builtin_amdgcn_rcpf(fmaxf(bflo(hw.x), 1e-18f)); g0[1] *= __builtin_amdgcn_rcpf(fmaxf(bfhi(hw.x), 1e-18f));
                        g0[2] *= __builtin_amdgcn_rcpf(fmaxf(bflo(hw.y), 1e-18f)); g0[3] *= __builtin_amdgcn_rcpf(fmaxf(bfhi(hw.y), 1e-18f));
                        g1[0] *= __builtin_amdgcn_rcpf(fmaxf(bflo(hw.z), 1e-18f)); g1[1] *= __builtin_amdgcn_rcpf(fmaxf(bfhi(hw.z), 1e-18f));
                        g1[2] *= __builtin_amdgcn_rcpf(fmaxf(bflo(hw.w), 1e-18f)); g1[3] *= __builtin_amdgcn_rcpf(fmaxf(bfhi(hw.w), 1e-18f));
                        acc[ai][bj][m][0] = acc[ai][bj][m][0] * g0; acc[ai][bj][m][1] = acc[ai][bj][m][1] * g1;
                    } else {
                        const f32x4 v0 = acc[ai][bj][m][0] * g0, v1 = acc[ai][bj][m][1] * g1;
                        u32x4 w; w.x = pk2c(v0[0], v0[1]); w.y = pk2c(v0[2], v0[3]); w.z = pk2c(v1[0], v1[1]); w.w = pk2c(v1[2], v1[3]);
                        *(u32x4*)(Z + row * ZLD + ZC_M + col) = w;
                    }
                } }
            __builtin_amdgcn_sched_barrier(0);
        }
    }
};
struct EpiOut {
    bf16_t* O; float* SS;
    DI bool reset(const Unit&) const { return true; }
    DI void operator()(AccT& acc, const Unit& u, int wr, int wc, int fr, int fq) const {
        asm volatile("" : "+v"(fr), "+v"(fq));
#pragma unroll
        for (int ai = 0; ai < 2; ++ai)
#pragma unroll
            for (int m = 0; m < 4; ++m) {
                const int rt = ai * 128 + wr * 64 + m * 16 + fr; const size_t row = (size_t)u.pm * 256 + rt; float s = 0.f;
#pragma unroll
                for (int bj = 0; bj < 2; ++bj) {
                    const int col = u.pn * 256 + bj * 128 + wc * 32 + 8 * fq; const f32x4 v0 = acc[ai][bj][m][0], v1 = acc[ai][bj][m][1];
                    s += (v0[0] * v0[0] + v0[1] * v0[1]) + (v0[2] * v0[2] + v0[3] * v0[3]); s += (v1[0] * v1[0] + v1[1] * v1[1]) + (v1[2] * v1[2] + v1[3] * v1[3]);
                    u32x4 w; w.x = pk2c(v0[0], v0[1]); w.y = pk2c(v0[2], v0[3]); w.z = pk2c(v1[0], v1[1]); w.w = pk2c(v1[2], v1[3]);
                    *(u32x4*)(O + row * DM + col) = w;
                }
                s += __shfl_xor(s, 16); s += __shfl_xor(s, 32);
                if (fq == 0) SS[row * 16 + u.pn * 4 + wc] = s;
            }
    }
};
struct EpiFfn {
    bf16_t* Hd;
    DI bool reset(const Unit&) const { return true; }
    DI void operator()(AccT& acc, const Unit& u, int wr, int wc, int fr, int fq) const {
        asm volatile("" : "+v"(fr), "+v"(fq));
#pragma unroll
        for (int ai = 0; ai < 2; ++ai)
#pragma unroll
            for (int m = 0; m < 4; ++m) {
                const int rt = ai * 128 + wr * 64 + m * 16 + fr; const size_t row = (size_t)u.pm * 256 + rt;
                const int col = u.pn * 128 + wc * 32 + 8 * fq; f32x4 v0, v1;
#pragma unroll
                for (int e = 0; e < 4; ++e) { const float g0 = acc[ai][0][m][0][e], g1 = acc[ai][0][m][1][e];
                    v0[e] = g0 * sigmoidf_(g0) * acc[ai][1][m][0][e]; v1[e] = g1 * sigmoidf_(g1) * acc[ai][1][m][1][e]; }
                u32x4 w; w.x = pk2c(v0[0], v0[1]); w.y = pk2c(v0[2], v0[3]); w.z = pk2c(v1[0], v1[1]); w.w = pk2c(v1[2], v1[3]);
                *(u32x4*)(Hd + row * DFF + col) = w;
            }
    }
};
}

namespace att {
constexpr int KROWB = 144, KBUF = 64 * KROWB, VBUF = 16384;
constexpr int L_K = 0, L_V = 2 * KBUF, L_WS = L_V + 2 * VBUF, L_END = L_WS + 8 * 256;
constexpr float SCALE = 0.125f, CL2 = SCALE * 1.4426950408889634f, THRS = 8.f / SCALE;
DI int crow(int r, int hi) { return (r & 3) + 8 * (r >> 2) + 4 * hi; }
DI unsigned cvtpk(float lo, float hi) { unsigned r; asm volatile("v_cvt_pk_bf16_f32 %0, %1, %2" : "=v"(r) : "v"(lo), "v"(hi)); return r; }
template <int DV> DI int v_st(int k, int c) { constexpr int NCB = DV / 32; const int kk = (k & ~0xC) | ((k & 4) << 1) | ((k & 8) >> 1); return ((kk >> 3) * NCB + (c >> 5)) * 512 + ((kk & 7) * 32 + (c & 31)) * 2; }
DI int v_rd_base(int lane) { return ((lane & 3) << 3) | (((lane >> 2) & 3) << 6) | (((lane >> 4) & 1) << 5) | (((lane >> 5) & 1) << 8); }
template <int DV> constexpr int v_rd_off(int d0, int ks, int half) { return d0 * 512 + (ks * 2 + half) * (DV / 32) * 512; }
template <int OFF> DI s16x4 tr_read(int vb) { s16x4 r; asm volatile("ds_read_b64_tr_b16 %0, %1 offset:%2" : "=&v"(r) : "v"(vb), "i"(OFF) : "memory"); return r; }
template <int DV, int D0> DI void pv_one(f32x16& od, int vb, bf16x8 pa0, bf16x8 pa1, bf16x8 pa2, bf16x8 pa3) {
    const s16x4 l0 = tr_read<v_rd_off<DV>(D0, 0, 0)>(vb), h0 = tr_read<v_rd_off<DV>(D0, 0, 1)>(vb), l1 = tr_read<v_rd_off<DV>(D0, 1, 0)>(vb), h1 = tr_read<v_rd_off<DV>(D0, 1, 1)>(vb);
    const s16x4 l2 = tr_read<v_rd_off<DV>(D0, 2, 0)>(vb), h2 = tr_read<v_rd_off<DV>(D0, 2, 1)>(vb), l3 = tr_read<v_rd_off<DV>(D0, 3, 0)>(vb), h3 = tr_read<v_rd_off<DV>(D0, 3, 1)>(vb);
    asm volatile("s_waitcnt lgkmcnt(0)" ::: "memory"); __builtin_amdgcn_sched_barrier(0);
#define ATT_PK(L, H) (bf16x8){L[0], L[1], L[2], L[3], H[0], H[1], H[2], H[3]}
    od = __builtin_amdgcn_mfma_f32_32x32x16_bf16(pa0, ATT_PK(l0, h0), od, 0, 0, 0);
    od = __builtin_amdgcn_mfma_f32_32x32x16_bf16(pa1, ATT_PK(l1, h1), od, 0, 0, 0);
    od = __builtin_amdgcn_mfma_f32_32x32x16_bf16(pa2, ATT_PK(l2, h2), od, 0, 0, 0);
    od = __builtin_amdgcn_mfma_f32_32x32x16_bf16(pa3, ATT_PK(l3, h3), od, 0, 0, 0);
#undef ATT_PK
}
struct TileList { int a0, na, b0, nb; };

template <int DV, bool MASK>
DI void attn_pass(LAS unsigned char* lds, const bf16_t* __restrict__ Zb, size_t qoff, int kcol, int vcol, const TileList tl, int jq, int qpos0, float m_init, float l_init, f32x16 (&o)[DV / 32], float& l_out) {
    constexpr int NCB = DV / 32;
    int tid_ = threadIdx.x; asm volatile("" : "+v"(tid_));
    const int tid = tid_, wid = tid >> 6, lane = tid & 63, r32 = lane & 31, hi = lane >> 5;
    LAS unsigned char* Kl = lds + L_K; LAS unsigned char* Vl = lds + L_V; LAS float* wsf = (LAS float*)(lds + L_WS) + wid * 64;
    bf16x8 qr[4];
#pragma unroll
    for (int d0 = 0; d0 < 4; ++d0) qr[d0] = *(const bf16x8*)(Zb + qoff + (size_t)r32 * ZLD + d0 * 16 + hi * 8);
    const int krow_t = tid >> 3, kch = tid & 7;
    const size_t kg = (size_t)krow_t * ZLD + kcol + kch * 8; const int kl = krow_t * KROWB + kch * 16;
    const int sr = (DV == 128) ? (tid >> 4) : (tid >> 3), sc = (DV == 128) ? (tid & 15) * 8 : (tid & 7) * 8;
    const size_t vg0 = (size_t)sr * ZLD + vcol + sc, vg1 = (size_t)(32 + sr) * ZLD + vcol + sc;
    const int vl0 = v_st<DV>(sr, sc), vl1 = v_st<DV>(32 + sr, sc);
    const int vb0 = (int)(uintptr_t)Vl + v_rd_base(lane);
    const int NT = tl.na + tl.nb;
#define ATT_TILE(j) ((j) < tl.na ? tl.a0 + (j) : tl.b0 + ((j) - tl.na))
    bf16x8 ks, vs0, vs1 = {};
#define ATT_GLOAD(j) do { const bf16_t* tb_ = Zb + (size_t)ATT_TILE(j) * 64 * ZLD; ks = *(const bf16x8*)(tb_ + kg); vs0 = *(const bf16x8*)(tb_ + vg0); if (DV == 128) vs1 = *(const bf16x8*)(tb_ + vg1); } while (0)
#define ATT_SWRITE(b) do { *(LAS bf16x8*)(Kl + (b) * KBUF + kl) = ks; *(LAS bf16x8*)(Vl + (b) * VBUF + vl0) = vs0; if (DV == 128) *(LAS bf16x8*)(Vl + (b) * VBUF + vl1) = vs1; } while (0)
    float m_reg = m_init, l_reg = l_init;
#pragma unroll
    for (int d = 0; d < NCB; ++d)
#pragma unroll
        for (int r = 0; r < 16; ++r) o[d][r] = 0.f;
    ATT_GLOAD(0); ATT_SWRITE(0); if (NT > 1) ATT_GLOAD(1);
    __syncthreads();
    for (int j = 0; j < NT; ++j) {
        const int cur = j & 1;
        if (j + 1 < NT) ATT_SWRITE(cur ^ 1);
        if (j + 2 < NT) ATT_GLOAD(j + 2);
        const LAS unsigned char* Kb = Kl + cur * KBUF;
        f32x16 p0, p1;
#pragma unroll
        for (int r = 0; r < 16; ++r) { p0[r] = 0.f; p1[r] = 0.f; }
#pragma unroll
        for (int d0 = 0; d0 < 4; ++d0) { const int cb = d0 * 32 + hi * 16;
            const bf16x8 b0 = *(const LAS bf16x8*)(Kb + r32 * KROWB + cb), b1 = *(const LAS bf16x8*)(Kb + (32 + r32) * KROWB + cb);
            p0 = __builtin_amdgcn_mfma_f32_32x32x16_bf16(b0, qr[d0], p0, 0, 0, 0);
            p1 = __builtin_amdgcn_mfma_f32_32x32x16_bf16(b1, qr[d0], p1, 0, 0, 0); }
        if (MASK) { const int t = ATT_TILE(j);
            if (j >= tl.na && (t == jq - 2 || t == jq + 2)) { const int dq = t * 64 - qpos0 - r32;
#pragma unroll
                for (int r = 0; r < 16; ++r) { const int d0_ = dq + crow(r, hi), d1_ = d0_ + 32;
                    if (d0_ > 128 || d0_ < -128) p0[r] = -1e30f; if (d1_ > 128 || d1_ < -128) p1[r] = -1e30f; } } }
        float pmax = p0[0];
#pragma unroll
        for (int r = 1; r < 16; ++r) pmax = fmaxf(pmax, p0[r]);
#pragma unroll
        for (int r = 0; r < 16; ++r) pmax = fmaxf(pmax, p1[r]);
        { auto rr = __builtin_amdgcn_permlane32_swap(__float_as_uint(pmax), __float_as_uint(pmax), false, false); pmax = fmaxf(__uint_as_float(rr[0]), __uint_as_float(rr[1])); }
        float mn, alpha;
        if (__all(pmax - m_reg <= THRS)) { mn = m_reg; alpha = 1.f; }
        else { mn = fmaxf(m_reg, pmax); alpha = __builtin_amdgcn_exp2f((m_reg - mn) * CL2); m_reg = mn; }
        const float mnC = -mn * CL2;
#pragma unroll
        for (int r = 0; r < 16; ++r) { p0[r] = __builtin_amdgcn_exp2f(fmaf(p0[r], CL2, mnC)); p1[r] = __builtin_amdgcn_exp2f(fmaf(p1[r], CL2, mnC)); }
        float ps = 0.f;
#pragma unroll
        for (int r = 0; r < 16; ++r) ps += p0[r] + p1[r];
        { auto rr = __builtin_amdgcn_permlane32_swap(__float_as_uint(ps), __float_as_uint(ps), false, false); ps = __uint_as_float(rr[0]) + __uint_as_float(rr[1]); }
        l_reg = l_reg * alpha + ps;
        if (__any(alpha < 1.f)) {
            if (hi == 0) wsf[r32] = alpha;
            asm volatile("s_waitcnt lgkmcnt(0)" ::: "memory");
#pragma unroll
            for (int r = 0; r < 16; ++r) { const float a = wsf[crow(r, hi)];
#pragma unroll
                for (int d = 0; d < NCB; ++d) o[d][r] *= a; }
        }
        bf16x8 pa0, pa1, pa2, pa3;
#define ATT_PK4(P, BASE, OUT) do { unsigned a0 = cvtpk(P[BASE + 0], P[BASE + 1]), a1 = cvtpk(P[BASE + 2], P[BASE + 3]); \
        unsigned b0_ = cvtpk(P[BASE + 4], P[BASE + 5]), b1_ = cvtpk(P[BASE + 6], P[BASE + 7]); \
        auto r0 = __builtin_amdgcn_permlane32_swap(a0, b0_, false, false); auto r1 = __builtin_amdgcn_permlane32_swap(a1, b1_, false, false); \
        u32x4 w = {r0[0], r1[0], r0[1], r1[1]}; OUT = __builtin_bit_cast(bf16x8, w); } while (0)
        ATT_PK4(p0, 0, pa0); ATT_PK4(p0, 8, pa1); ATT_PK4(p1, 0, pa2); ATT_PK4(p1, 8, pa3);
#undef ATT_PK4
        const int vb = vb0 + cur * VBUF;
        pv_one<DV, 0>(o[0], vb, pa0, pa1, pa2, pa3); pv_one<DV, 1>(o[1], vb, pa0, pa1, pa2, pa3);
        if constexpr (DV == 128) { pv_one<DV, 2>(o[2], vb, pa0, pa1, pa2, pa3); pv_one<DV, 3>(o[3], vb, pa0, pa1, pa2, pa3); }
        __syncthreads();
    }
    l_out = l_reg;
#undef ATT_TILE
#undef ATT_GLOAD
#undef ATT_SWRITE
}
DI void partialSM(f32x16& p0, f32x16& p1, float& m_reg, float& mn, float& alpha) {
    float pmax = p0[0];
#pragma unroll
    for (int r = 1; r < 16; ++r) pmax = fmaxf(pmax, p0[r]);
#pragma unroll
    for (int r = 0; r < 16; ++r) pmax = fmaxf(pmax, p1[r]);
    { auto rr = __builtin_amdgcn_permlane32_swap(__float_as_uint(pmax), __float_as_uint(pmax), false, false); pmax = fmaxf(__uint_as_float(rr[0]), __uint_as_float(rr[1])); }
    if (__builtin_expect(__all(pmax - m_reg <= THRS), 1)) { mn = m_reg; alpha = 1.f; }
    else { mn = fmaxf(m_reg, pmax); alpha = __builtin_amdgcn_exp2f((m_reg - mn) * CL2); m_reg = mn; }
    const float mnC = -mn * CL2;
#pragma unroll
    for (int r = 0; r < 16; ++r) p0[r] = fmaf(p0[r], CL2, mnC);
#pragma unroll
    for (int r = 0; r < 16; ++r) p1[r] = fmaf(p1[r], CL2, mnC);
#pragma unroll
    for (int r = 0; r < 16; ++r) p0[r] = __builtin_amdgcn_exp2f(p0[r]);
}
DI void finishSM(f32x16& p0, f32x16& p1, float alpha, float& l_reg, bf16x8& pa0, bf16x8& pa1, bf16x8& pa2, bf16x8& pa3) {
#pragma unroll
    for (int r = 0; r < 16; ++r) p1[r] = __builtin_amdgcn_exp2f(p1[r]);
    float ps = 0.f;
#pragma unroll
    for (int r = 0; r < 16; ++r) ps += p0[r];
#pragma unroll
    for (int r = 0; r < 16; ++r) ps += p1[r];
    { auto rr = __builtin_amdgcn_permlane32_swap(__float_as_uint(ps), __float_as_uint(ps), false, false); ps = __uint_as_float(rr[0]) + __uint_as_float(rr[1]); }
    l_reg = l_reg * alpha + ps;
#define ATT_PK4(P, BASE, OUT) do { unsigned a0 = cvtpk(P[BASE + 0], P[BASE + 1]), a1 = cvtpk(P[BASE + 2], P[BASE + 3]); \
    unsigned b0_ = cvtpk(P[BASE + 4], P[BASE + 5]), b1_ = cvtpk(P[BASE + 6], P[BASE + 7]); \
    auto r0 = __builtin_amdgcn_permlane32_swap(a0, b0_, false, false); auto r1 = __builtin_amdgcn_permlane32_swap(a1, b1_, false, false); \
    u32x4 w = {r0[0], r1[0], r0[1], r1[1]}; OUT = __builtin_bit_cast(bf16x8, w); } while (0)
    ATT_PK4(p0, 0, pa0); ATT_PK4(p0, 8, pa1); ATT_PK4(p1, 0, pa2); ATT_PK4(p1, 8, pa3);
#undef ATT_PK4
}
DI void qkt64(f32x16& p0, f32x16& p1, const LAS unsigned char* Kb, const bf16x8 (&qr)[4], int r32, int hi) {
#pragma unroll
    for (int r = 0; r < 16; ++r) { p0[r] = 0.f; p1[r] = 0.f; }
#pragma unroll
    for (int d0 = 0; d0 < 4; ++d0) { const int cb = d0 * 32 + hi * 16;
        const bf16x8 b0 = *(const LAS bf16x8*)(Kb + r32 * KROWB + cb), b1 = *(const LAS bf16x8*)(Kb + (32 + r32) * KROWB + cb);
        p0 = __builtin_amdgcn_mfma_f32_32x32x16_bf16(b0, qr[d0], p0, 0, 0, 0);
        p1 = __builtin_amdgcn_mfma_f32_32x32x16_bf16(b1, qr[d0], p1, 0, 0, 0); }
}
DI void pv128(f32x16 (&o)[4], int vb, bf16x8 pa0, bf16x8 pa1, bf16x8 pa2, bf16x8 pa3) {
    pv_one<128, 0>(o[0], vb, pa0, pa1, pa2, pa3); pv_one<128, 1>(o[1], vb, pa0, pa1, pa2, pa3); pv_one<128, 2>(o[2], vb, pa0, pa1, pa2, pa3); pv_one<128, 3>(o[3], vb, pa0, pa1, pa2, pa3);
}
DI void attn_pass_pipe(LAS unsigned char* lds, const bf16_t* __restrict__ Zb, size_t qoff, int kcol, int vcol, int t0, int NT, f32x16 (&o)[4], float& l_out) {
    int tid_ = threadIdx.x; asm volatile("" : "+v"(tid_));
    const int tid = tid_, wid = tid >> 6, lane = tid & 63, r32 = lane & 31, hi = lane >> 5;
    LAS unsigned char* Kl = lds + L_K; LAS unsigned char* Vl = lds + L_V; LAS float* wsf = (LAS float*)(lds + L_WS) + wid * 64;
    bf16x8 qr[4];
#pragma unroll
    for (int d0 = 0; d0 < 4; ++d0) qr[d0] = *(const bf16x8*)(Zb + qoff + (size_t)r32 * ZLD + d0 * 16 + hi * 8);
    const int krow_t = tid >> 3, kch = tid & 7;
    const bf16_t* kgp = Zb + (size_t)t0 * 64 * ZLD + (size_t)krow_t * ZLD + kcol + kch * 8; const int kl = krow_t * KROWB + kch * 16;
    const int sr = tid >> 4, sc = (tid & 15) * 8;
    const bf16_t* vgp0 = Zb + (size_t)t0 * 64 * ZLD + (size_t)sr * ZLD + vcol + sc; const bf16_t* vgp1 = vgp0 + (size_t)32 * ZLD;
    const int vl0 = v_st<128>(sr, sc), vl1 = v_st<128>(32 + sr, sc);
    const int vb0 = (int)(uintptr_t)Vl + v_rd_base(lane);
    constexpr size_t TSTEP = (size_t)64 * ZLD;
    bf16x8 ksE, v0E, v1E, ksO, v0O, v1O;
#define PP_LOADE(j) do { ksE = *(const bf16x8*)(kgp + (size_t)(j) * TSTEP); v0E = *(const bf16x8*)(vgp0 + (size_t)(j) * TSTEP); v1E = *(const bf16x8*)(vgp1 + (size_t)(j) * TSTEP); } while (0)
#define PP_LOADO(j) do { ksO = *(const bf16x8*)(kgp + (size_t)(j) * TSTEP); v0O = *(const bf16x8*)(vgp0 + (size_t)(j) * TSTEP); v1O = *(const bf16x8*)(vgp1 + (size_t)(j) * TSTEP); } while (0)
#define PP_WRITEE() do { *(LAS bf16x8*)(Kl + kl) = ksE; *(LAS bf16x8*)(Vl + vl0) = v0E; *(LAS bf16x8*)(Vl + vl1) = v1E; } while (0)
#define PP_WRITEO() do { *(LAS bf16x8*)(Kl + KBUF + kl) = ksO; *(LAS bf16x8*)(Vl + VBUF + vl0) = v0O; *(LAS bf16x8*)(Vl + VBUF + vl1) = v1O; } while (0)
#define PP_RESC(a) do { if (__any((a) < 1.f)) { if (hi == 0) wsf[r32] = (a); asm volatile("s_waitcnt lgkmcnt(0)" ::: "memory"); \
    _Pragma("unroll") for (int r = 0; r < 16; ++r) { const float a_ = wsf[crow(r, hi)]; _Pragma("unroll") for (int d = 0; d < 4; ++d) o[d][r] *= a_; } } } while (0)
#define PP_SB() __builtin_amdgcn_sched_barrier(0)
    float m_reg = -1e30f, l_reg = 0.f;
#pragma unroll
    for (int d = 0; d < 4; ++d)
#pragma unroll
        for (int r = 0; r < 16; ++r) o[d][r] = 0.f;
    f32x16 pA0, pA1, pB0, pB1; float mnA, mnB, alA, alB; bf16x8 pa0, pa1, pa2, pa3;
    if (__builtin_amdgcn_readfirstlane(wid) >= 4) __builtin_amdgcn_s_setprio(1);
    PP_LOADE(0); PP_WRITEE(); __syncthreads();
    qkt64(pA0, pA1, Kl, qr, r32, hi); partialSM(pA0, pA1, m_reg, mnA, alA);
    PP_LOADO(1); PP_LOADE(2);
    PP_WRITEO(); __syncthreads();
    for (int j = 1; j + 1 < NT; j += 2) {
        PP_SB(); qkt64(pB0, pB1, Kl + KBUF, qr, r32, hi);
        finishSM(pA0, pA1, alA, l_reg, pa0, pa1, pa2, pa3); PP_SB();
        PP_LOADO(j + 2); PP_SB();
        pv128(o, vb0, pa0, pa1, pa2, pa3); partialSM(pB0, pB1, m_reg, mnB, alB);
        __syncthreads(); PP_WRITEE();
        PP_RESC(alB); __syncthreads();
        PP_SB(); qkt64(pA0, pA1, Kl, qr, r32, hi);
        finishSM(pB0, pB1, alB, l_reg, pa0, pa1, pa2, pa3); PP_SB();
        if (j + 3 < NT) PP_LOADE(j + 3); PP_SB();
        pv128(o, vb0 + VBUF, pa0, pa1, pa2, pa3); partialSM(pA0, pA1, m_reg, mnA, alA);
        __syncthreads(); PP_WRITEO();
        PP_RESC(alA); __syncthreads();
    }
    PP_SB(); qkt64(pB0, pB1, Kl + KBUF, qr, r32, hi);
    finishSM(pA0, pA1, alA, l_reg, pa0, pa1, pa2, pa3); PP_SB();
    pv128(o, vb0, pa0, pa1, pa2, pa3); partialSM(pB0, pB1, m_reg, mnB, alB);
    __syncthreads(); PP_RESC(alB);
    finishSM(pB0, pB1, alB, l_reg, pa0, pa1, pa2, pa3); PP_SB();
    pv128(o, vb0 + VBUF, pa0, pa1, pa2, pa3);
    __builtin_amdgcn_s_setprio(0);
    __syncthreads();
    l_out = l_reg;
#undef PP_LOADE
#undef PP_LOADO
#undef PP_WRITEE
#undef PP_WRITEO
#undef PP_RESC
#undef PP_SB
}
DI void row_rcp(LAS unsigned char* lds, float l, float (&rli)[16]) {
    int tid_ = threadIdx.x; asm volatile("" : "+v"(tid_));
    const int tid = tid_, wid = tid >> 6, lane = tid & 63, r32 = lane & 31, hi = lane >> 5;
    LAS float* wsf = (LAS float*)(lds + L_WS) + wid * 64;
    if (hi == 0) wsf[32 + r32] = l;
    asm volatile("s_waitcnt lgkmcnt(0)" ::: "memory");
#pragma unroll
    for (int r = 0; r < 16; ++r) rli[r] = __builtin_amdgcn_rcpf(wsf[32 + crow(r, hi)]);
}
}

DI void transpose_item(const float* __restrict__ W, int N, bf16_t* WT, int ldt, int koff, int item, int nblk, bool ffnmap, LAS float* scr, int lane) {
    const int kb = item / nblk, nb = item % nblk, k0 = 64 * kb, n0 = 32 * nb;
#pragma unroll 8
    for (int i = 0; i < 32; ++i) { const int kk = 2 * i + (lane >> 5); scr[kk * 33 + (lane & 31)] = W[(size_t)(k0 + kk) * N + n0 + (lane & 31)]; }
    asm volatile("s_waitcnt lgkmcnt(0)" ::: "memory");
    const int c = lane & 7;
#pragma unroll
    for (int j = 0; j < 4; ++j) { const int n = (lane >> 3) + 8 * j; const LAS float* s = scr + (8 * c) * 33 + n;
        u32x4 o; o.x = pk2(s[0 * 33], s[1 * 33]); o.y = pk2(s[2 * 33], s[3 * 33]); o.z = pk2(s[4 * 33], s[5 * 33]); o.w = pk2(s[6 * 33], s[7 * 33]);
        int drow = n0 + n;
        if (ffnmap) { drow = (drow < DFF) ? ((drow >> 7) * 256 + (drow & 127)) : ((((drow - DFF) >> 7) * 256) + 128 + ((drow - DFF) & 127)); }
        *(u32x4*)(WT + (size_t)drow * ldt + koff + k0 + 8 * c) = o; }
    asm volatile("s_waitcnt lgkmcnt(0)" ::: "memory");
}

DI void conv_weights(const Cx& a, int l, LAS unsigned char* lds, int tid, int gw, int NGW, int p_lo, int p_hi) {
    const int lane = tid & 63, wave = tid >> 6;
    LAS float* scr = (LAS float*)(lds + wave * 8704);
    unsigned char* wb = a.ws + wb_off(l);
    const float* w_in = a.inp(7) + (size_t)l * DM * INW; const float* w_br = a.inp(13) + (size_t)l * 3 * 512 * DM; const float* w_o = a.inp(14) + (size_t)l * DM * DM;
    const float* w_fi = a.inp(15) + (size_t)l * DM * 2 * DFF; const float* w_fo = a.inp(16) + (size_t)l * DFF * DM;
    constexpr int I_IN = (DM / 64) * (INW / 32), I_B = (512 / 64) * (DM / 32), I_O = (DM / 64) * (DM / 32), I_FI = (DM / 64) * (2 * DFF / 32), I_FO = (DFF / 64) * (DM / 32);
    constexpr int NITEMS = I_IN + 2 * I_B + I_O + I_FI + I_FO;
    const int np = p_hi - p_lo;
    for (int jt = gw; jt < (NITEMS / 8) * np; jt += NGW) {
        const int it = (jt / np) * 8 + p_lo + jt % np; int r = it;
        if (r < I_IN) { transpose_item(w_in, INW, (bf16_t*)(wb + WB_IN), DM, 0, r, INW / 32, false, scr, lane); continue; } r -= I_IN;
        if (r < I_B) { transpose_item(w_br, DM, (bf16_t*)(wb + WB_BR), 1536, 0, r, DM / 32, false, scr, lane); continue; } r -= I_B;
        if (r < I_B) { transpose_item(w_br + (size_t)2 * 512 * DM, DM, (bf16_t*)(wb + WB_BR), 1536, 1024, r, DM / 32, false, scr, lane); continue; } r -= I_B;
        if (r < I_O) { transpose_item(w_o, DM, (bf16_t*)(wb + WB_O), DM, 0, r, DM / 32, false, scr, lane); continue; } r -= I_O;
        if (r < I_FI) { transpose_item(w_fi, 2 * DFF, (bf16_t*)(wb + WB_FI), DM, 0, r, 2 * DFF / 32, true, scr, lane); continue; } r -= I_FI;
        transpose_item(w_fo, DM, (bf16_t*)(wb + WB_FO), DFF, 0, r, DM / 32, false, scr, lane);
    }
    const float* wp = a.inp(10) + (size_t)l * 4 * 128 * 128; const float* psc = a.inp(11) + (size_t)l * 512; const float* wb1 = w_br + (size_t)512 * DM;
    bf16_t* WbT = (bf16_t*)(wb + WB_BR);
    for (int jt = gw; jt < (512 * (DM / 64) / 8) * np; jt += NGW) { const int it = (jt / np) * 8 + p_lo + jt % np;
        const int kc = it >> 4, n = (it & 15) * 64 + lane, g = kc >> 7; const float* wrow = wp + (size_t)kc * 128; const float* pss = psc + g * 128; const float* wbc = wb1 + (size_t)(g * 128) * DM + n;
        float s0 = 0.f, s1 = 0.f, s2 = 0.f, s3 = 0.f;
#pragma unroll 4
        for (int d = 0; d < 128; d += 4) {
            s0 += wrow[d] * pss[d] * wbc[(size_t)d * DM]; s1 += wrow[d + 1] * pss[d + 1] * wbc[(size_t)(d + 1) * DM];
            s2 += wrow[d + 2] * pss[d + 2] * wbc[(size_t)(d + 2) * DM]; s3 += wrow[d + 3] * pss[d + 3] * wbc[(size_t)(d + 3) * DM]; }
        WbT[(size_t)n * 1536 + 512 + kc] = (bf16_t)f2bf((s0 + s1) + (s2 + s3));
    }
}

DI void rowpass(const Cx& a, int mode, int l, int tid, int gw, int NGW) {
    const int lane = tid & 63;
    const float* MOD = (const float*)(a.ws + WS_MOD); const float* SS = (const float*)(a.ws + WS_SS); bf16_t* H = (bf16_t*)(a.ws + WS_H);
    bf16_t* XL = (bf16_t*)a.out; bf16_t* XCb = (bf16_t*)(a.ws + WS_XC); bf16_t* XA = (bf16_t*)(a.ws + WS_Z + 400 * MiB);
    const float* normg = a.inp(6); const float* xin = a.inp(0); const float* cin = a.inp(2);
    const int chunk = (ROWS + NGW - 1) / NGW; const int r0 = gw * chunk; const int r1 = (r0 + chunk < ROWS) ? r0 + chunk : ROWS;
    if (r0 >= r1) return;
    const bool lastl = (l == DEPTH - 1);
    const bool last = (mode == 2 && lastl);
    const bool skipc = (mode != 0 && lastl);
    const int l2 = (mode == 2) ? l + 1 : l; const int k2 = (mode == 1) ? 2 : 0;
    f32x4 gnv[4], g2v[4], gtv[4], shv[4], scv[4];
#pragma unroll
    for (int j = 0; j < 4; ++j) { const int c = 4 * lane + 256 * j;
        gnv[j] = (mode == 0) ? (f32x4){0.f, 0.f, 0.f, 0.f} : *(const f32x4*)(normg + ((size_t)l * 4 + (mode == 1 ? 1 : 3)) * DM + c);
        g2v[j] = last ? (f32x4){0.f, 0.f, 0.f, 0.f} : *(const f32x4*)(normg + ((size_t)l2 * 4 + k2) * DM + c);
        gtv[j] = (f32x4){0.f, 0.f, 0.f, 0.f}; shv[j] = gtv[j]; scv[j] = gtv[j]; }
    int cur_mv = -1;
    f32x4 xfc[4], xfn[4]; u32x2 xbc[4], xbn[4]; u32x2 yc[4], yn[4]; float sc_ = 0.f, sn_ = 0.f;
#define RP_XSRC(b_, n_) ((n_) < SEQ ? ((mode == 2 && lastl) ? XA : XL) + ((size_t)(b_) * SEQ + (n_)) * DM : XCb + ((size_t)(b_) * CTXL + ((n_) - SEQ)) * DM)
#define RP_XDST(b_, n_) ((n_) < SEQ ? ((mode == 1 && lastl) ? XA : XL) + ((size_t)(b_) * SEQ + (n_)) * DM : XCb + ((size_t)(b_) * CTXL + ((n_) - SEQ)) * DM)
#define RP_LOAD(row, XF, XB, Y, S_) do { const int b_ = (row) / NB, n_ = (row) - b_ * NB; \
        if (mode == 0) { const float* sp_ = (n_ < SEQ) ? xin + ((size_t)b_ * SEQ + n_) * DM : cin + ((size_t)b_ * CTXL + (n_ - SEQ)) * DM; \
            _Pragma("unroll") for (int j = 0; j < 4; ++j) XF[j] = *(const f32x4*)(sp_ + 4 * lane + 256 * j); } \
        else { const bf16_t* sp_ = RP_XSRC(b_, n_); \
            _Pragma("unroll") for (int j = 0; j < 4; ++j) { XB[j] = *(const u32x2*)(sp_ + 4 * lane + 256 * j); Y[j] = *(const u32x2*)(H + (size_t)(row) * DM + 4 * lane + 256 * j); } \
            S_ = SS[(size_t)(row) * 16 + (lane & 15)]; } } while (0)
    RP_LOAD(r0, xfc, xbc, yc, sc_);
    for (int row = r0; row < r1; ++row) {
        if (row + 1 < r1) RP_LOAD(row + 1, xfn, xbn, yn, sn_);
        const int b = row / NB, n = row - b * NB; const bool lat = n < SEQ; const int mv = lat ? b : 16;
        if (!(skipc && !lat)) {
            if (mv != cur_mv) { cur_mv = mv;
                const float* mb = MOD + ((size_t)l * NMOD + mv) * MODW; const float* mb2 = MOD + ((size_t)l2 * NMOD + mv) * MODW;
#pragma unroll
                for (int j = 0; j < 4; ++j) { const int c = 4 * lane + 256 * j;
                    if (mode != 0) gtv[j] = *(const f32x4*)(mb + (mode == 1 ? 2 * DM : 5 * DM) + c);
                    if (!last) { shv[j] = *(const f32x4*)(mb2 + (mode == 1 ? 3 * DM : 0) + c); scv[j] = *(const f32x4*)(mb2 + (mode == 1 ? 4 * DM : DM) + c); } } }
            f32x4 v[4];
            if (mode == 0) {
#pragma unroll
                for (int j = 0; j < 4; ++j) v[j] = xfc[j];
            } else {
                float ss = sc_;
                ss += __shfl_xor(ss, 1); ss += __shfl_xor(ss, 2); ss += __shfl_xor(ss, 4); ss += __shfl_xor(ss, 8);
                const float rstd = rsqrtf(ss * (1.f / DM) + EPS);
#pragma unroll
                for (int j = 0; j < 4; ++j) { f32x4 y, x; y[0] = bflo(yc[j].x); y[1] = bfhi(yc[j].x); y[2] = bflo(yc[j].y); y[3] = bfhi(yc[j].y);
                    x[0] = bflo(xbc[j].x); x[1] = bfhi(xbc[j].x); x[2] = bflo(xbc[j].y); x[3] = bfhi(xbc[j].y);
                    v[j] = x + gtv[j] * (y * rstd * gnv[j]); }
            }
            if (last) {
                float* op = a.out + ((size_t)b * SEQ + n) * DM;
#pragma unroll
                for (int j = 0; j < 4; ++j) *(f32x4*)(op + 4 * lane + 256 * j) = v[j];
            } else {
                bf16_t* xp = RP_XDST(b, n);
#pragma unroll
                for (int j = 0; j < 4; ++j) { u32x2 w; w.x = pk2c(v[j][0], v[j][1]); w.y = pk2c(v[j][2], v[j][3]); *(u32x2*)(xp + 4 * lane + 256 * j) = w; }
                float s2 = 0.f;
#pragma unroll
                for (int j = 0; j < 4; ++j) s2 += (v[j][0] * v[j][0] + v[j][1] * v[j][1]) + (v[j][2] * v[j][2] + v[j][3] * v[j][3]);
                const float rinv = rsqrtf(wave_sum(s2) * (1.f / DM) + EPS);
#pragma unroll
                for (int j = 0; j < 4; ++j) { const f32x4 h = v[j] * rinv * g2v[j] * (1.f + scv[j]) + shv[j]; u32x2 w; w.x = pk2c(h[0], h[1]); w.y = pk2c(h[2], h[3]);
                    *(u32x2*)(H + (size_t)row * DM + 4 * lane + 256 * j) = w; }
            }
        }
#pragma unroll
        for (int j = 0; j < 4; ++j) { xfc[j] = xfn[j]; xbc[j] = xbn[j]; yc[j] = yn[j]; }
        sc_ = sn_;
    }
#undef RP_XSRC
#undef RP_XDST
#undef RP_LOAD
}

DI void da_unit(const Cx& a, LAS unsigned char* lds, int l, int u, int N_DA_L) {
    int tid_ = threadIdx.x; asm volatile("" : "+v"(tid_));
    const int tid = tid_, lane = tid & 63, wave = tid >> 6, r32 = lane & 31, hi = lane >> 5;
    bf16_t* Z = (bf16_t*)(a.ws + WS_Z); bf16_t* H = (bf16_t*)(a.ws + WS_H);
    const float lam = ((const float*)(a.ws + WS_LAM))[l]; const float lam_init = 0.8f - 0.6f * expf(-0.3f * (float)l);
    int b, h, qb;
    if (u < N_DA_L) { b = u >> 6; h = (u >> 4) & 3; qb = u & 15; } else { const int c = u - N_DA_L; b = c >> 2; h = c & 3; qb = 16; }
    const bf16_t* Zb = Z + (size_t)b * NB * ZLD;
    const int q0 = qb * 256 + wave * 32;
    att::TileList tl; tl.a0 = (qb < 16) ? 0 : 64; tl.na = (qb < 16) ? 68 : 4; tl.b0 = 0; tl.nb = 0;
    float* stash = (float*)((unsigned char*)H + ((size_t)a.bx * 256 + wave * 32) * (DM * 2) + 1024);
    f32x16 o[4]; float lsum; float rli[16];
    att::attn_pass_pipe(lds, Zb, (size_t)q0 * ZLD + ZC_QA + h * 128, ZC_KA + h * 128, ZC_VA + h * 128, tl.a0, tl.na, o, lsum);
    att::row_rcp(lds, lsum, rli);
#pragma unroll
    for (int r = 0; r < 16; ++r)
#pragma unroll
        for (int d = 0; d < 4; ++d) stash[att::crow(r, hi) * 512 + d * 32 + r32] = o[d][r] * rli[r];
    att::attn_pass_pipe(lds, Zb, (size_t)q0 * ZLD + ZC_QA + h * 128 + 64, ZC_KA + h * 128 + 64, ZC_VA + h * 128, tl.a0, tl.na, o, lsum);
    att::row_rcp(lds, lsum, rli);
    const float* gsub = a.inp(9) + l * 128; const float g0 = gsub[r32], g1 = gsub[32 + r32], g2 = gsub[64 + r32], g3 = gsub[96 + r32]; const float post = 1.f - lam_init;
#pragma unroll
    for (int r = 0; r < 16; ++r) { const int rr = att::crow(r, hi); float v[4]; float sq = 0.f;
#pragma unroll
        for (int d = 0; d < 4; ++d) { v[d] = stash[rr * 512 + d * 32 + r32] - lam * (o[d][r] * rli[r]); sq += v[d] * v[d]; }
        sq += __shfl_xor(sq, 1); sq += __shfl_xor(sq, 2); sq += __shfl_xor(sq, 4); sq += __shfl_xor(sq, 8); sq += __shfl_xor(sq, 16);
        const float rn = rsqrtf(sq * (1.f / 128.f) + EPS) * post;
        bf16_t* op = Z + ((size_t)b * NB + q0 + rr) * ZLD + ZC_QA + h * 128 + r32;
        op[0] = (bf16_t)f2bf(v[0] * rn * g0); op[32] = (bf16_t)f2bf(v[1] * rn * g1); op[64] = (bf16_t)f2bf(v[2] * rn * g2); op[96] = (bf16_t)f2bf(v[3] * rn * g3); }
}
DI void wa_unit(const Cx& a, LAS unsigned char* lds, int l, int b, int kvh, int jq) {
    int tid_ = threadIdx.x; asm volatile("" : "+v"(tid_));
    const int tid = tid_, lane = tid & 63, wave = tid >> 6, r32 = lane & 31, hi = lane >> 5;
    bf16_t* Z = (bf16_t*)(a.ws + WS_Z);
    const bf16_t* Zb = Z + (size_t)b * NB * ZLD;
    const int head = kvh * 4 + (wave >> 1), q0 = jq * 64 + (wave & 1) * 32;
    att::TileList tl; tl.a0 = 64; tl.na = 4;
    if (jq < 64) { const int lo = jq - 2 < 0 ? 0 : jq - 2, hi_t = jq + 2 > 63 ? 63 : jq + 2; tl.b0 = lo; tl.nb = hi_t - lo + 1; } else { tl.b0 = 0; tl.nb = 0; }
    const float sink = a.inp(12)[l * 8 + head];
    f32x16 o[2]; float lsum; float rli[16];
    att::attn_pass<64, true>(lds, Zb, (size_t)q0 * ZLD + ZC_QW + head * 64, ZC_KW + kvh * 64, ZC_VW + kvh * 64, tl, jq, q0, sink * (1.f / att::SCALE), 1.f, o, lsum);
    att::row_rcp(lds, lsum, rli);
#pragma unroll
    for (int r = 0; r < 16; ++r) { bf16_t* op = Z + ((size_t)b * NB + q0 + att::crow(r, hi)) * ZLD + ZC_QW + head * 64 + r32;
        op[0] = (bf16_t)f2bf(o[0][r] * rli[r]); op[32] = (bf16_t)f2bf(o[1][r] * rli[r]); }
}
DI void pool_rows(const Cx& a, int l, int tid, int gw, int NGW) {
    const int lane = tid & 63;
    bf16_t* Z = (bf16_t*)(a.ws + WS_Z);
    const int chunk = (ROWS + NGW - 1) / NGW; const int r0 = gw * chunk; const int r1 = (r0 + chunk < ROWS) ? r0 + chunk : ROWS;
    if (r0 >= r1) return;
    const int g = lane >> 4, hw = 1 << g;
    const bf16_t* ucol = Z + ZC_U + lane * 8;
    float sum[8];
#pragma unroll
    for (int e = 0; e < 8; ++e) sum[e] = 0.f;
#define PL_LOAD(row, WA_, WR_, WS_) do { const int b_ = (row) / NB, n_ = (row) - b_ * NB; const bool lat_ = n_ < SEQ; const int t_ = lat_ ? n_ : n_ - SEQ, ns_ = lat_ ? SEQ : CTXL; const int rb_ = (row) - t_; \
        int ja_ = t_ + hw - 1; ja_ = ja_ < ns_ ? ja_ : ns_ - 1; int jr_ = t_ - 1 - hw; jr_ = jr_ < 0 ? 0 : jr_; \
        WA_ = *(const u32x4*)(ucol + (size_t)(rb_ + ja_) * ZLD); WR_ = *(const u32x4*)(ucol + (size_t)(rb_ + jr_) * ZLD); WS_ = *(const u32x4*)(ucol + (size_t)(row) * ZLD); } while (0)
#define PL_ACC(W, F) do { sum[0] += (F) * bflo(W.x); sum[1] += (F) * bfhi(W.x); sum[2] += (F) * bflo(W.y); sum[3] += (F) * bfhi(W.y); sum[4] += (F) * bflo(W.z); sum[5] += (F) * bfhi(W.z); sum[6] += (F) * bflo(W.w); sum[7] += (F) * bfhi(W.w); } while (0)
    u32x4 wa, wr, ws_, na, nr, ns;
    PL_LOAD(r0, wa, wr, ws_);
    bool need_init = true;
    for (int row = r0; row < r1; ++row) {
        if (row + 1 < r1) PL_LOAD(row + 1, na, nr, ns);
        const int b = row / NB, n = row - b * NB; const bool lat = n < SEQ; const int t = lat ? n : n - SEQ, nseq = lat ? SEQ : CTXL; const int rbase = row - t;
        if (l == DEPTH - 1 && !lat) { need_init = true; }
        else {
            const int lo = t - hw < 0 ? 0 : t - hw, hi_ = t + hw > nseq ? nseq : t + hw;
            if (need_init || t == 0) {
                need_init = false;
#pragma unroll
                for (int e = 0; e < 8; ++e) sum[e] = 0.f;
                u32x4 w[16];
#pragma unroll
                for (int jj = 0; jj < 16; ++jj) { int j = lo + jj; j = j < hi_ ? j : hi_ - 1; w[jj] = *(const u32x4*)(ucol + (size_t)(rbase + j) * ZLD); }
#pragma unroll
                for (int jj = 0; jj < 16; ++jj) { const float f = (lo + jj < hi_) ? 1.f : 0.f; PL_ACC(w[jj], f); }
            } else {
                const float fa = (t + hw - 1 < nseq) ? 1.f : 0.f, fr = (t - 1 - hw >= 0) ? -1.f : 0.f;
                PL_ACC(wa, fa); PL_ACC(wr, fr);
            }
            const float ic = 1.f / (float)(hi_ - lo);
            u32x4 o; o.x = pk2c(sum[0] * ic - bflo(ws_.x), sum[1] * ic - bfhi(ws_.x)); o.y = pk2c(sum[2] * ic - bflo(ws_.y), sum[3] * ic - bfhi(ws_.y));
            o.z = pk2c(sum[4] * ic - bflo(ws_.z), sum[5] * ic - bfhi(ws_.z)); o.w = pk2c(sum[6] * ic - bflo(ws_.w), sum[7] * ic - bfhi(ws_.w));
            *(u32x4*)(Z + (size_t)row * ZLD + ZC_PL + lane * 8) = o;
        }
        wa = na; wr = nr; ws_ = ns;
    }
#undef PL_LOAD
#undef PL_ACC
}

DI Cx make_cx(const Args& a0) {
    Cx c; GAS unsigned char* w = (GAS unsigned char*)a0.ws; GAS float* o = (GAS float*)a0.out; int G = gridDim.x, bx = blockIdx.x;
    asm volatile("" : "+s"(w), "+s"(o), "+s"(G), "+s"(bx));
    c.ws = (unsigned char*)w; c.out = (float*)o; c.G = G; c.bx = bx; c.vcu = (G % 8 == 0) ? (bx % 8) * (G / 8) + bx / 8 : bx;
    c.tab = (const float* const*)(c.ws + WS_TAB) + bx * 32;
    return c;
}
DI void phase0(const Cx& a, LAS unsigned char* lds) {
    int tid_ = threadIdx.x; asm volatile("" : "+v"(tid_));
    const int tid = tid_, lane = tid & 63, wave = tid >> 6, G = a.G, bx = a.bx;
    const int gw = a.vcu * 8 + wave, NGW = G * 8, gtid = bx * 512 + tid, NGT = G * 512;
    float* MOD = (float*)(a.ws + WS_MOD); float* ROPE = (float*)(a.ws + WS_ROPE); float* LAM = (float*)(a.ws + WS_LAM);
    LAS float* sl = (LAS float*)lds;
    LAS float* red = (LAS float*)(lds + 17 * 1024 * 4);
    const float* cvec = a.inp(1); const float* cctx = a.inp(3); const float* wada = a.inp(4); const float* bada = a.inp(5);
    bool filled = false;
    for (int it = bx; it < DEPTH * 96; it += G) {
        if (!filled) { for (int i = tid; i < NMOD * DM; i += 512) { const int v = i >> 10, k = i & 1023; const float c = (v < 16) ? cvec[v * DM + k] : cctx[k]; sl[i] = c * sigmoidf_(c); } filled = true; __syncthreads(); }
        const int l = it / 96, cb = it % 96, col = cb * 64 + lane;
        const float* wa = wada + (size_t)l * DM * MODW + col;
        float acc[NMOD];
#pragma unroll
        for (int v = 0; v < NMOD; ++v) acc[v] = 0.f;
        for (int k = wave * 128; k < wave * 128 + 128; k += 4) {
            const float w0 = wa[(size_t)k * MODW], w1 = wa[(size_t)(k + 1) * MODW], w2 = wa[(size_t)(k + 2) * MODW], w3 = wa[(size_t)(k + 3) * MODW];
#pragma unroll
            for (int v = 0; v < NMOD; ++v) { const f32x4 s = *(const LAS f32x4*)(sl + v * DM + k); acc[v] += (s[0] * w0 + s[1] * w1) + (s[2] * w2 + s[3] * w3); }
        }
#pragma unroll
        for (int v = 0; v < NMOD; ++v) red[(wave * NMOD + v) * 64 + lane] = acc[v];
        __syncthreads();
        for (int i = tid; i < NMOD * 64; i += 512) { const int v = i >> 6, ln = i & 63; float s = bada[(size_t)l * MODW + cb * 64 + ln];
#pragma unroll
            for (int w = 0; w < 8; ++w) s += red[(w * NMOD + v) * 64 + ln];
            MOD[((size_t)l * NMOD + v) * MODW + cb * 64 + ln] = s; }
        __syncthreads();
    }
    __syncthreads();
    for (int i = gtid; i < SEQ * 32; i += NGT) { const int n = i >> 5, f = i & 31; const float pos = (f < 16) ? (float)(n >> 6) : (float)(n & 63);
        const float inv = exp2f(-(float)(f & 15) * (13.287712379549449f / 16.f)); const float ang = pos * inv; ROPE[2 * i] = __cosf(ang); ROPE[2 * i + 1] = __sinf(ang); }
    if (bx == 0 && tid < DEPTH) { const float* lp = a.inp(8) + tid * 256; float s01 = 0.f, s23 = 0.f;
        for (int i = 0; i < 64; ++i) { s01 += lp[i] * lp[64 + i]; s23 += lp[128 + i] * lp[192 + i]; }
        LAM[tid] = __expf(s01) - __expf(s23) + (0.8f - 0.6f * __expf(-0.3f * (float)tid)); }
    conv_weights(a, 0, lds, tid, gw, NGW, 0, 8);
}
DI void phase_rows(const Cx& a, int mode, int l) { int tid_ = threadIdx.x; asm volatile("" : "+v"(tid_)); rowpass(a, mode, l, tid_, a.vcu * 8 + (tid_ >> 6), a.G * 8); }
DI void phase_conv(const Cx& a, int l, LAS unsigned char* lds, int p_lo, int p_hi) { int tid_ = threadIdx.x; asm volatile("" : "+v"(tid_));
    const int first = (a.G == 256) ? 64 : 0; if (a.bx < first) return;
    conv_weights(a, l, lds, tid_, (a.bx - first) * 8 + (tid_ >> 6), (a.G - first) * 8, p_lo, p_hi); }
DI void phase_attn(const Cx& a, LAS unsigned char* lds, int l) {
    constexpr int N_DA_L = NBATCH * 4 * 16;
    const bool lastl = (l == DEPTH - 1);
    for (int u = a.vcu; u < N_DA_L; u += a.G) da_unit(a, lds, l, u, N_DA_L);
    const int nstat = 7 * a.G;
    for (int w = a.vcu; w < nstat && w < 2048; w += a.G) wa_unit(a, lds, l, w >> 7, (w >> 6) & 1, w & 63);
    const int nDAc = lastl ? 0 : 64, nWL = (2048 > nstat) ? 2048 - nstat : 0, nWS = lastl ? 0 : 128, total = nDAc + nWL + nWS;
    unsigned* head = (unsigned*)(a.ws + WS_QCTR) + l * 64;
    volatile LAS unsigned* slot = (volatile LAS unsigned*)(lds + 131072 + 128);
    int tid_ = threadIdx.x; asm volatile("" : "+v"(tid_));
    unsigned nxt = 0u;
    if (tid_ == 0) nxt = __hip_atomic_fetch_add(head, 1u, __ATOMIC_RELAXED, __HIP_MEMORY_SCOPE_AGENT);
    for (;;) {
        __syncthreads();
        if (tid_ == 0) *slot = nxt;
        __syncthreads();
        const int idx = (int)*slot;
        if (idx >= total) break;
        if (tid_ == 0) nxt = __hip_atomic_fetch_add(head, 1u, __ATOMIC_RELAXED, __HIP_MEMORY_SCOPE_AGENT);
        if (idx < nDAc) da_unit(a, lds, l, N_DA_L + idx, N_DA_L);
        else if (idx < nDAc + nWL) { const int w = nstat + (idx - nDAc); wa_unit(a, lds, l, w >> 7, (w >> 6) & 1, w & 63); }
        else { const int s_ = idx - nDAc - nWL; wa_unit(a, lds, l, s_ >> 3, (s_ >> 2) & 1, 64 + (s_ & 3)); }
    }
}
DI void phase_pool(const Cx& a, int l) { int tid_ = threadIdx.x; asm volatile("" : "+v"(tid_)); pool_rows(a, l, tid_, a.vcu * 8 + (tid_ >> 6), a.G * 8); }
DI void phase_g1(const Cx& a, LAS unsigned char* lds, int l) {
    pg8::SchedPlain S; S.skipctx = (l == DEPTH - 1); S.ctxkv = S.skipctx ? 80 : 0; S.T.init(S.skipctx ? 256 : ROWS / 256, INW / 256, a.G, a.bx); S.A = (const char*)(a.ws + WS_H); S.lda2 = DM * 2; S.B = (const char*)(a.ws + wb_off(l) + WB_IN); S.ldb2 = DM * 2;
    { int tid_ = threadIdx.x; asm volatile("" : "+v"(tid_)); const float* R = (const float*)(a.ws + WS_ROPE); LAS float* T = (LAS float*)(lds + 131072 + 1024);
      for (int e = tid_; e < 64 * 16; e += 512) { const int pos = e >> 4, f = e & 15; T[2 * e] = R[((size_t)pos * 32 + 16 + f) * 2]; T[2 * e + 1] = R[((size_t)pos * 32 + 16 + f) * 2 + 1]; }
      __syncthreads(); }
    pg8::EpiIn E{(bf16_t*)(a.ws + WS_Z), (const LAS float*)(lds + 131072 + 1024)}; pg8::gemm_phase(lds, DM * 2, DM * 2, DM / 64, S, E); }
DI void phase_g2(const Cx& a, LAS unsigned char* lds, int l) {
    pg8::SchedMerge S; S.skipctx = (l == DEPTH - 1); S.T.init(S.skipctx ? 256 : ROWS / 256, DM / 256, a.G, a.bx); S.Z = (const char*)(a.ws + WS_Z); S.H = (const char*)(a.ws + WS_H); S.Wb = (const char*)(a.ws + wb_off(l) + WB_BR);
    pg8::EpiMerge E{(bf16_t*)(a.ws + WS_Z)}; pg8::gemm_phase(lds, ZLD * 2, 1536 * 2, 512 / 64, S, E); }
DI void phase_g3(const Cx& a, LAS unsigned char* lds, int l) {
    pg8::SchedPlain S; S.skipctx = (l == DEPTH - 1); S.T.init(S.skipctx ? 256 : ROWS / 256, DM / 256, a.G, a.bx); S.A = (const char*)(a.ws + WS_Z + ZC_M * 2); S.lda2 = ZLD * 2; S.B = (const char*)(a.ws + wb_off(l) + WB_O); S.ldb2 = DM * 2;
    pg8::EpiOut E{(bf16_t*)(a.ws + WS_H), (float*)(a.ws + WS_SS)}; pg8::gemm_phase(lds, ZLD * 2, DM * 2, DM / 64, S, E); }
DI void phase_g4(const Cx& a, LAS unsigned char* lds, int l) {
    pg8::SchedPlain S; S.skipctx = (l == DEPTH - 1); S.T.init(S.skipctx ? 256 : ROWS / 256, 2 * DFF / 256, a.G, a.bx); S.A = (const char*)(a.ws + WS_H); S.lda2 = DM * 2; S.B = (const char*)(a.ws + wb_off(l) + WB_FI); S.ldb2 = DM * 2;
    pg8::EpiFfn E{(bf16_t*)(a.ws + WS_Z)}; pg8::gemm_phase(lds, DM * 2, DM * 2, DM / 64, S, E); }
DI void phase_g5(const Cx& a, LAS unsigned char* lds, int l) {
    pg8::SchedPlain S; S.skipctx = (l == DEPTH - 1); S.T.init(S.skipctx ? 256 : ROWS / 256, DM / 256, a.G, a.bx); S.T.rev = true; S.A = (const char*)(a.ws + WS_Z); S.lda2 = DFF * 2; S.B = (const char*)(a.ws + wb_off(l) + WB_FO); S.ldb2 = DFF * 2;
    pg8::EpiOut E{(bf16_t*)(a.ws + WS_H), (float*)(a.ws + WS_SS)}; pg8::gemm_phase(lds, DFF * 2, DFF * 2, DFF / 64, S, E); }

#ifndef PHM
#define PHM 0xFFFF
#endif
__global__ void __launch_bounds__(512, 2) fwd_kernel(Args a0) {
    extern __shared__ __attribute__((aligned(16))) unsigned char lds_raw[];
    LAS unsigned char* lds = (LAS unsigned char*)lds_raw;
    cg::grid_group grid = cg::this_grid();
    if (threadIdx.x == 0) {
        const float** t = (const float**)(a0.ws + WS_TAB) + blockIdx.x * 32;
        t[0] = a0.in[0]; t[1] = a0.in[1]; t[2] = a0.in[2]; t[3] = a0.in[3]; t[4] = a0.in[4]; t[5] = a0.in[5]; t[6] = a0.in[6]; t[7] = a0.in[7]; t[8] = a0.in[8];
        t[9] = a0.in[9]; t[10] = a0.in[10]; t[11] = a0.in[11]; t[12] = a0.in[12]; t[13] = a0.in[13]; t[14] = a0.in[14]; t[15] = a0.in[15]; t[16] = a0.in[16];
        __threadfence();
    }
    __syncthreads();
    volatile LAS unsigned* xst = (volatile LAS unsigned*)(lds + 131072 + 64);
    if (threadIdx.x < 2) xst[threadIdx.x] = 0u;
    if (blockIdx.x == 0) { unsigned* bw = (unsigned*)(a0.ws + WS_BAR); for (int i = threadIdx.x; i < XCD_BAR_WORDS; i += 512) bw[i] = 0u; }
    if (blockIdx.x == 0 && threadIdx.x < DEPTH) ((unsigned*)(a0.ws + WS_QCTR))[threadIdx.x * 64] = 0u;
    if (PHM & 1) { const Cx a = make_cx(a0); phase0(a, lds); }
    grid.sync();
    if (threadIdx.x == 0) (void)xb_add((unsigned*)(a0.ws + WS_BAR) + XB_XCNT(xb_xcc_id()), 1u);
#define GSYNC() xcd_barrier((unsigned*)(a0.ws + WS_BAR), xst)
    if (PHM & 2) { const Cx a = make_cx(a0); phase_rows(a, 0, 0); }
    GSYNC();
#pragma unroll 1
    for (int l = 0; l < DEPTH; ++l) {
        if (PHM & 4) { const Cx a = make_cx(a0); phase_g1(a, lds, l); }
        GSYNC();
        if (PHM & 8) { const Cx a = make_cx(a0); phase_attn(a, lds, l); }
        GSYNC();
        if (PHM & 2048) { const Cx a = make_cx(a0); phase_pool(a, l); }
        GSYNC();
        if (PHM & 16) { const Cx a = make_cx(a0); phase_g2(a, lds, l); if (l + 1 < DEPTH) phase_conv(a, l + 1, lds, 0, 5); }
        GSYNC();
        if (PHM & 32) { const Cx a = make_cx(a0); phase_g3(a, lds, l); }
        GSYNC();
        if (PHM & 64) { const Cx a = make_cx(a0); phase_rows(a, 1, l); }
        GSYNC();
        if (PHM & 128) { const Cx a = make_cx(a0); phase_g4(a, lds, l); }
        GSYNC();
        if (PHM & 256) { const Cx a = make_cx(a0); phase_g5(a, lds, l); if (l + 1 < DEPTH) phase_conv(a, l + 1, lds, 5, 8); }
        GSYNC();
        if (PHM & 512) { const Cx a = make_cx(a0); phase_rows(a, 2, l); }
        if (l + 1 < DEPTH) GSYNC();
    }
}

extern "C" void kernel_launch(void* const* d_in, const int* in_sizes, int n_in, void* d_out, int out_size, void* d_ws, size_t ws_size, hipStream_t stream) {
    static int grid = 0;
    if (grid == 0) {
        if (n_in != 17 || out_size != NBATCH * SEQ * DM || ws_size < WS_END) { fprintf(stderr, "kernel_launch: unexpected shapes (n_in %d out %d ws %zu, need ws >= %zu)\n", n_in, out_size, ws_size, (size_t)WS_END); grid = -1; return; }
        int dev = 0, cus = 0, per = 0;
        hipGetDevice(&dev); hipDeviceGetAttribute(&cus, hipDeviceAttributeMultiprocessorCount, dev);
        if (hipFuncSetAttribute((const void*)fwd_kernel, hipFuncAttributeMaxDynamicSharedMemorySize, LDS_BYTES) != hipSuccess) { fprintf(stderr, "kernel_launch: hipFuncSetAttribute failed\n"); grid = -1; return; }
        hipOccupancyMaxActiveBlocksPerMultiprocessor(&per, (const void*)fwd_kernel, 512, LDS_BYTES);
        (void)hipGetLastError();
        if (per < 1) { fprintf(stderr, "kernel_launch: occupancy query says %d blocks per CU\n", per); per = 1; }
        grid = cus;
        if (grid > 256) grid = 256;
    }
    if (grid < 0) return;
    Args a{};
    for (int i = 0; i < 17; ++i) a.in[i] = (const float*)d_in[i];
    a.out = (float*)d_out; a.ws = (unsigned char*)d_ws;
    void* args[] = {&a};
    hipError_t e = hipLaunchCooperativeKernel((const void*)fwd_kernel, dim3(grid), dim3(512), args, LDS_BYTES, stream);
    if (e != hipSuccess) fprintf(stderr, "kernel_launch: cooperative launch failed: %s (grid %d)\n", hipGetErrorString(e), grid);
}
```
